# Optimizing an MI355X kernel written in HIP

```python
import math
import jax
import jax.numpy as jnp
from jax import lax
import numpy as np

D_MODEL = 1024
BATCH = 4
SEQ = 8192
DEPTH = 2

HEAD_DIM = 64
BAND = 128
MASK_VALUE = -1e30

A_HEADS = 6
A_PATTERNS = ((128, 1), (512, 4), (2048, 16))

B_HEADS = 4
B_KEY_DIM = 128
B_VAL_DIM = 96
B_CHUNK = 64

C_HEADS = 4
C_KV_HEADS = 2
C_WINDOW = 128

A_WIDTH = A_HEADS * HEAD_DIM
B_KEY_WIDTH = B_HEADS * B_KEY_DIM
B_WIDTH = B_HEADS * B_VAL_DIM
C_WIDTH = C_HEADS * HEAD_DIM
C_KV_WIDTH = C_KV_HEADS * HEAD_DIM
MIX_WIDTH = A_WIDTH + B_WIDTH + C_WIDTH
IN_SPLITS = (A_WIDTH, A_WIDTH, A_WIDTH, B_KEY_WIDTH, B_KEY_WIDTH, B_WIDTH, B_WIDTH, C_WIDTH, C_KV_WIDTH, C_KV_WIDTH)
IN_WIDTH = sum(IN_SPLITS)

REL_BUCKETS = 32
REL_MAX_DIST = 2048
REL_HEADS = A_HEADS + C_HEADS

N_EXPERTS = 256
TOP_K = 8
N_GROUPS = 8
TOPK_GROUPS = 4
EXPERT_FF = 256
SHARED_FF = 256
ROUTED_SCALE = 2.5
MOE_BLOCK = 128

DEEPNORM_ALPHA = (2 * DEPTH) ** 0.25
DEEPNORM_BETA = (8 * DEPTH) ** -0.25
LN_EPS = 1e-5

kernel_name = "hybrid_dilated_hgrn2_sinkswa_moe_deepnorm"


def layer_norm(x, g, b):
    x = x.astype(jnp.float32)
    mu = jnp.mean(x, axis=-1, keepdims=True)
    xc = x - mu
    var = jnp.mean(xc * xc, axis=-1, keepdims=True)
    return xc * lax.rsqrt(var + LN_EPS) * g.astype(jnp.float32) + b.astype(jnp.float32)


def rel_bucket(dist):
    max_exact = REL_BUCKETS // 2
    d = jnp.maximum(dist, 0)
    log_ratio = jnp.log(jnp.maximum(d, max_exact).astype(jnp.float32) / max_exact) / math.log(REL_MAX_DIST / max_exact)
    large = jnp.minimum(max_exact + (log_ratio * (REL_BUCKETS - max_exact)).astype(jnp.int32), REL_BUCKETS - 1)
    return jnp.where(d < max_exact, d, large)


def band_offsets():
    return jnp.arange(BAND)[:, None] + BAND - jnp.arange(2 * BAND)[None, :]


def band_keys(t):
    n, h, length, d = t.shape
    tb = t.reshape(n, h, length // BAND, BAND, d)
    prev = jnp.pad(tb[:, :, :-1], ((0, 0), (0, 0), (1, 0), (0, 0), (0, 0)))
    return jnp.concatenate([prev, tb], axis=3)


def band_logits(q, k, bias, max_dist):
    n, h, length, d = q.shape
    nb = length // BAND
    qb = q.reshape(n, h, nb, BAND, d)
    s = jnp.einsum("nhbqd,nhbkd->nhbqk", qb, band_keys(k)) * (d ** -0.5) + bias[None, :, None]
    dist = band_offsets()
    in_band = (dist >= 0) & (dist <= max_dist)
    has_prev = (jnp.arange(nb)[:, None, None] > 0) | (jnp.arange(2 * BAND) >= BAND)[None, None, :]
    mask = in_band[None] & has_prev
    return jnp.where(mask[None, None], s, MASK_VALUE)


def to_residues(t, r, lp):
    b, h, s, d = t.shape
    t = t.reshape(b, h, s // r, r, d).transpose(0, 3, 1, 2, 4).reshape(b * r, h, s // r, d)
    return jnp.pad(t, ((0, 0), (0, 0), (0, lp - s // r), (0, 0)))


def from_residues(t, b, r, length):
    _, h, _, d = t.shape
    t = t[:, :, :length].reshape(b, r, h, length, d).transpose(0, 2, 3, 1, 4)
    return t.reshape(b, h, length * r, d)


def dilated_attention(q, k, v, rel_table):
    b, s, _ = q.shape
    heads = lambda t: t.reshape(b, s, A_HEADS, HEAD_DIM).transpose(0, 2, 1, 3)
    q, k, v = heads(q), heads(k), heads(v)
    dist_units = band_offsets()
    outs, lses = [], []
    for window, r in A_PATTERNS:
        length = s // r
        lp = -(-length // BAND) * BAND
        qr, kr, vr = to_residues(q, r, lp), to_residues(k, r, lp), to_residues(v, r, lp)
        bias = rel_table[rel_bucket(dist_units * r)][..., :A_HEADS].transpose(2, 0, 1)
        logits = band_logits(qr, kr, bias, window // r)
        m = jnp.max(logits, axis=-1, keepdims=True)
        p = jnp.exp(logits - m)
        den = jnp.sum(p, axis=-1, keepdims=True)
        o = jnp.einsum("nhbqk,nhbkd->nhbqd", p, band_keys(vr)) / den
        lse = m + jnp.log(den)
        outs.append(from_residues(o.reshape(b * r, A_HEADS, lp, HEAD_DIM), b, r, length))
        lses.append(from_residues(lse.reshape(b * r, A_HEADS, lp, 1), b, r, length))
    weights = jax.nn.softmax(jnp.stack(lses), axis=0)
    o = jnp.sum(weights * jnp.stack(outs), axis=0)
    return o.transpose(0, 2, 1, 3).reshape(b, s, A_WIDTH)


def hgrn2(q, f_logit, inp, gate, lower_bound, norm_g):
    b, s, _ = q.shape
    nc = s // B_CHUNK
    forget = lower_bound + (1.0 - lower_bound) * jax.nn.sigmoid(f_logit)
    log_f = jnp.log(forget)
    key = (1.0 - lower_bound) * jax.nn.sigmoid(-f_logit)
    chunks = lambda t, dim: t.reshape(b, nc, B_CHUNK, B_HEADS, dim).transpose(1, 0, 3, 2, 4)
    qc = chunks(jax.nn.silu(q), B_KEY_DIM)
    kc = chunks(key, B_KEY_DIM)
    gc = chunks(log_f, B_KEY_DIM)
    ic = chunks(inp, B_VAL_DIM)
    causal = jnp.tril(jnp.ones((B_CHUNK, B_CHUNK), dtype=bool))[:, :, None]

    def step(state, xs):
        qq, kk, ii, gg = xs
        cum = jnp.cumsum(gg, axis=2)
        inter = jnp.einsum("bhtk,bhkv->bhtv", qq * jnp.exp(cum), state)
        diff = cum[:, :, :, None, :] - cum[:, :, None, :, :]
        decay = jnp.where(causal, jnp.exp(jnp.where(causal, diff, 0.0)), 0.0)
        scores = jnp.einsum("bhtk,bhsk,bhtsk->bhts", qq, kk, decay)
        intra = jnp.einsum("bhts,bhsv->bhtv", scores, ii)
        last = cum[:, :, -1]
        k_dec = kk * jnp.exp(last[:, :, None] - cum)
        new_state = jnp.exp(last)[..., None] * state + jnp.einsum("bhsk,bhsv->bhkv", k_dec, ii)
        return new_state, inter + intra

    state0 = jnp.zeros((b, B_HEADS, B_KEY_DIM, B_VAL_DIM), jnp.float32)
    _, o = lax.scan(step, state0, (qc, kc, ic, gc))
    o = o.transpose(1, 0, 3, 2, 4).reshape(b, s, B_HEADS, B_VAL_DIM)
    o = o * lax.rsqrt(jnp.mean(o * o, axis=-1, keepdims=True) + 1e-6)
    return o.reshape(b, s, B_WIDTH) * norm_g * jax.nn.silu(gate)


def sink_window_attention(q, k, v, rel_table, sinks):
    b, s, _ = q.shape
    rep = C_HEADS // C_KV_HEADS
    q = q.reshape(b, s, C_HEADS, HEAD_DIM).transpose(0, 2, 1, 3)
    k = jnp.repeat(k.reshape(b, s, C_KV_HEADS, HEAD_DIM).transpose(0, 2, 1, 3), rep, axis=1)
    v = jnp.repeat(v.reshape(b, s, C_KV_HEADS, HEAD_DIM).transpose(0, 2, 1, 3), rep, axis=1)
    bias = rel_table[rel_bucket(band_offsets())][..., A_HEADS:].transpose(2, 0, 1)
    logits = band_logits(q, k, bias, C_WINDOW - 1)
    sink = jnp.broadcast_to(sinks[None, :, None, None, None], logits.shape[:-1] + (1,))
    p = jax.nn.softmax(jnp.concatenate([logits, sink], axis=-1), axis=-1)[..., :-1]
    o = jnp.einsum("nhbqk,nhbkd->nhbqd", p, band_keys(v))
    return o.reshape(b, C_HEADS, s, HEAD_DIM).transpose(0, 2, 1, 3).reshape(b, s, C_WIDTH)


def mixer_sublayer(x, w_in, w_out, rel_table, lower_bound, b_norm_g, c_sinks):
    h = jnp.einsum("bsd,de->bse", x, w_in).astype(jnp.float32)
    split_at = [int(i) for i in np.cumsum(IN_SPLITS)[:-1]]
    aq, ak, av, bq, bf, bi, bg, cq, ck, cv = jnp.split(h, split_at, axis=-1)
    oa = dilated_attention(aq, ak, av, rel_table)
    ob = hgrn2(bq, bf, bi, bg, lower_bound, b_norm_g.astype(jnp.float32))
    oc = sink_window_attention(cq, ck, cv, rel_table, c_sinks.astype(jnp.float32))
    o = jnp.concatenate([oa, ob, oc], axis=-1)
    return jnp.einsum("bse,ed->bsd", o, w_out.astype(jnp.float32))


def moe_sublayer(x, router_w, router_bias, w_gate, w_up, w_down, sh_gate, sh_up, sh_down):
    b, s, d = x.shape
    t = b * s
    xt = x.reshape(t, d)
    scores = jax.nn.sigmoid(jnp.einsum("td,de->te", xt, router_w).astype(jnp.float32))
    choice = scores + router_bias.astype(jnp.float32)
    per_group = N_EXPERTS // N_GROUPS
    group_score = jnp.sum(lax.top_k(choice.reshape(t, N_GROUPS, per_group), 2)[0], axis=-1)
    top_groups = lax.top_k(group_score, TOPK_GROUPS)[1]
    group_ok = jnp.any(top_groups[:, :, None] == jnp.arange(N_GROUPS), axis=1)
    choice = jnp.where(jnp.repeat(group_ok, per_group, axis=1), choice, MASK_VALUE)
    top_e = lax.top_k(choice, TOP_K)[1]
    gate = jnp.take_along_axis(scores, top_e, axis=1)
    gate = gate / jnp.sum(gate, axis=-1, keepdims=True) * ROUTED_SCALE

    n = t * TOP_K
    flat_e = top_e.reshape(n)
    order = jnp.argsort(flat_e)
    sorted_e = flat_e[order]
    counts = jnp.bincount(flat_e, length=N_EXPERTS)
    padded = (counts + MOE_BLOCK - 1) // MOE_BLOCK * MOE_BLOCK
    pad_end = jnp.cumsum(padded)
    rank = jnp.arange(n) - (jnp.cumsum(counts) - counts)[sorted_e]
    dest = pad_end[sorted_e] - padded[sorted_e] + rank
    n_blocks = -(-(n + N_EXPERTS * (MOE_BLOCK - 1)) // MOE_BLOCK)
    rows = n_blocks * MOE_BLOCK
    row_tok = jnp.zeros((rows,), jnp.int32).at[dest].set((order // TOP_K).astype(jnp.int32))
    row_gate = jnp.zeros((rows,), jnp.float32).at[dest].set(gate.reshape(n)[order])
    block_e = jnp.minimum(jnp.searchsorted(pad_end, jnp.arange(n_blocks) * MOE_BLOCK, side="right"), N_EXPERTS - 1)

    def expert_block(args):
        tok, g, e = args
        xb = xt[tok]
        hb = jax.nn.silu(xb @ w_gate[e]) * (xb @ w_up[e])
        return (hb @ w_down[e]).astype(jnp.float32) * g[:, None]

    y = lax.map(expert_block, (row_tok.reshape(n_blocks, MOE_BLOCK), row_gate.reshape(n_blocks, MOE_BLOCK), block_e))
    routed = jax.ops.segment_sum(y.reshape(rows, d), row_tok, num_segments=t)
    shared = (jax.nn.silu(xt @ sh_gate) * (xt @ sh_up)) @ sh_down
    return (routed + shared.astype(jnp.float32)).reshape(b, s, d)


def setup_inputs(seed: int = 0) -> dict:
    key = jax.random.key(seed)
    ks = jax.random.split(key, 20)
    nrm = lambda k, shape, scale: jax.random.normal(k, shape, jnp.float32) * scale
    L = DEPTH
    return {
        "x": nrm(ks[0], (BATCH, SEQ, D_MODEL), 1.0),
        "w_in": nrm(ks[1], (L, D_MODEL, IN_WIDTH), D_MODEL ** -0.5),
        "w_out": nrm(ks[2], (L, MIX_WIDTH, D_MODEL), MIX_WIDTH ** -0.5 * DEEPNORM_BETA),
        "rel_bias_table": nrm(ks[3], (REL_BUCKETS, REL_HEADS), 0.5),
        "lower_bound_logits": nrm(ks[4], (L, B_KEY_WIDTH), 1.0),
        "hgrn_norm_g": 1.0 + nrm(ks[5], (L, B_WIDTH), 0.02),
        "attn_sinks": nrm(ks[6], (L, C_HEADS), 0.5),
        "ln1_g": 1.0 + nrm(ks[7], (L, D_MODEL), 0.02),
        "ln1_b": nrm(ks[8], (L, D_MODEL), 0.02),
        "router_w": nrm(ks[9], (L, D_MODEL, N_EXPERTS), D_MODEL ** -0.5),
        "router_bias": nrm(ks[10], (L, N_EXPERTS), 0.01),
        "expert_w_gate": nrm(ks[11], (L, N_EXPERTS, D_MODEL, EXPERT_FF), D_MODEL ** -0.5),
        "expert_w_up": nrm(ks[12], (L, N_EXPERTS, D_MODEL, EXPERT_FF), D_MODEL ** -0.5),
        "expert_w_down": nrm(ks[13], (L, N_EXPERTS, EXPERT_FF, D_MODEL), EXPERT_FF ** -0.5 * DEEPNORM_BETA),
        "shared_w_gate": nrm(ks[14], (L, D_MODEL, SHARED_FF), D_MODEL ** -0.5),
        "shared_w_up": nrm(ks[15], (L, D_MODEL, SHARED_FF), D_MODEL ** -0.5),
        "shared_w_down": nrm(ks[16], (L, SHARED_FF, D_MODEL), SHARED_FF ** -0.5 * DEEPNORM_BETA),
        "ln2_g": 1.0 + nrm(ks[17], (L, D_MODEL), 0.02),
        "ln2_b": nrm(ks[18], (L, D_MODEL), 0.02),
    }


def reference(x, w_in, w_out, rel_bias_table, lower_bound_logits, hgrn_norm_g, attn_sinks, ln1_g, ln1_b,
              router_w, router_bias, expert_w_gate, expert_w_up, expert_w_down,
              shared_w_gate, shared_w_up, shared_w_down, ln2_g, ln2_b):
    lb_probs = jax.nn.softmax(lower_bound_logits.astype(jnp.float32), axis=0)
    lower_bounds = jnp.cumsum(lb_probs, axis=0) - lb_probs[0]
    rel_table = rel_bias_table.astype(jnp.float32)
    h = x.astype(jnp.float32)
    for l in range(DEPTH):
        mix = mixer_sublayer(h, w_in[l], w_out[l], rel_table, lower_bounds[l], hgrn_norm_g[l], attn_sinks[l])
        h = layer_norm(DEEPNORM_ALPHA * h + mix, ln1_g[l], ln1_b[l])
        ffn = moe_sublayer(h, router_w[l], router_bias[l], expert_w_gate[l], expert_w_up[l], expert_w_down[l],
                           shared_w_gate[l], shared_w_up[l], shared_w_down[l])
        h = layer_norm(DEEPNORM_ALPHA * h + ffn, ln2_g[l], ln2_b[l])
    return h.astype(x.dtype)
```

```cpp
#include <hip/hip_runtime.h>
#include <cstdio>
#include <cstdint>

#define XB_TMO      128
#define XB_XCNT(j)  (256  + 64 * (j))
#define XB_XSUB(j)  (1280 + 64 * (j))
#define XB_XGEN(j)  (2304 + 64 * (j))
#define XB_TOP      3328
#define XB_TOPGEN   3392
#define XCD_BAR_WORDS 3456
#define XB_SPIN_CAP (1u << 23)
#define LAS __attribute__((address_space(3)))

__device__ __forceinline__ unsigned xb_ld(unsigned* p)              { return __hip_atomic_load(p, __ATOMIC_RELAXED, __HIP_MEMORY_SCOPE_AGENT); }
__device__ __forceinline__ unsigned xb_add(unsigned* p, unsigned v) { return __hip_atomic_fetch_add(p, v, __ATOMIC_RELAXED, __HIP_MEMORY_SCOPE_AGENT); }
__device__ __forceinline__ unsigned xb_xcc_id() { return (unsigned)__builtin_amdgcn_s_getreg((3 << 11) | 20) & 0xFu; }
#define XB_SPIN(cond, bar) do { unsigned _sp = 0; while (cond) { __builtin_amdgcn_s_sleep(1); \
    if ((++_sp & 255u) == 0u) { if (xb_ld(&(bar)[XB_TMO])) break; if (_sp > XB_SPIN_CAP) { atomicAdd(&(bar)[XB_TMO], 1u); break; } } } } while (0)

struct XcdBarrier { unsigned* bar; unsigned x; volatile LAS unsigned* st; };

__device__ __forceinline__ XcdBarrier xcd_barrier_post(unsigned* bar, volatile LAS unsigned* st) {
    XcdBarrier b; b.bar = bar; b.x = xb_xcc_id(); b.st = st;
    if (threadIdx.x == 0) (void)xb_add(&bar[XB_XCNT(b.x)], 1u);
    return b;
}
__device__ __forceinline__ void xcd_barrier_complete(unsigned* bar, unsigned x, unsigned& nloc, unsigned& nx) {
    const unsigned G = gridDim.x * gridDim.y * gridDim.z;
    unsigned sum, cnt, mine, sp = 0u;
    for (;;) {
        sum = 0u; cnt = 0u; mine = 0u;
#pragma unroll
        for (unsigned j = 0; j < 16; ++j) { const unsigned c = xb_ld(&bar[XB_XCNT(j)]); sum += c; cnt += (c > 0u) ? 1u : 0u; mine = (j == x) ? c : mine; }
        if (sum == G) break;
        __builtin_amdgcn_s_sleep(1);
        if ((++sp & 255u) == 0u) { if (xb_ld(&bar[XB_TMO])) break; if (sp > XB_SPIN_CAP) { atomicAdd(&bar[XB_TMO], 1u); break; } }
    }
    nloc = mine > 0u ? mine : 1u; nx = cnt > 0u ? cnt : 1u;
}
__device__ __forceinline__ void xcd_barrier(const XcdBarrier& b) {
    asm volatile("s_waitcnt vmcnt(0)" ::: "memory");
    __syncthreads();
    if (threadIdx.x == 0) {
        unsigned* bar = b.bar;
        __builtin_amdgcn_s_waitcnt(0);
        unsigned nloc = b.st[0], nx = b.st[1];
        if (nloc == 0u) { xcd_barrier_complete(bar, b.x, nloc, nx); b.st[0] = nloc; b.st[1] = nx; }
        const unsigned old = xb_add(&bar[XB_XSUB(b.x)], 1u);
        const unsigned gen = old / nloc;
        if (old + 1u == (gen + 1u) * nloc) {
            __builtin_amdgcn_fence(__ATOMIC_RELEASE, "agent");
            asm volatile("s_waitcnt vmcnt(0)" ::: "memory");
            const unsigned og = xb_add(&bar[XB_TOP], 1u);
            const unsigned tg = og / nx;
            if (og + 1u == (tg + 1u) * nx) xb_add(&bar[XB_TOPGEN], 1u);
            else XB_SPIN(xb_ld(&bar[XB_TOPGEN]) == tg, bar);
            __builtin_amdgcn_fence(__ATOMIC_ACQUIRE, "agent");
            xb_add(&bar[XB_XGEN(b.x)], 1u);
            asm volatile("s_waitcnt vmcnt(0)" ::: "memory");
        } else {
            XB_SPIN(xb_ld(&bar[XB_XGEN(b.x)]) == gen, bar);
            __builtin_amdgcn_fence(__ATOMIC_ACQUIRE, "agent");
            asm volatile("s_waitcnt vmcnt(0)" ::: "memory");
        }
    }
    __syncthreads();
}

typedef unsigned short u16;
typedef short s16x4 __attribute__((ext_vector_type(4)));
typedef short s16x8 __attribute__((ext_vector_type(8)));
typedef float f32x2 __attribute__((ext_vector_type(2)));
typedef float f32x4 __attribute__((ext_vector_type(4)));
typedef float f32x16 __attribute__((ext_vector_type(16)));
typedef __bf16 bf16x2_t __attribute__((ext_vector_type(2)));
typedef unsigned u32x4 __attribute__((ext_vector_type(4)));
typedef unsigned u32x2 __attribute__((ext_vector_type(2)));

#ifndef PHASE_MASK
#define PHASE_MASK 0xFFFF
#endif
#ifndef REPMASK
#define REPMASK 0
#endif
#define PH(k) if ((PHASE_MASK >> (k)) & 1) for (int rep_ = 0; rep_ < (((REPMASK >> (k)) & 1) ? 2 : 1); ++rep_)
namespace {
constexpr int T = 32768, D = 1024, SEQ = 8192, NBATCH = 4, DEPTH = 2;
constexpr int INW = 3456;
constexpr int NE = 256, FF = 256;
constexpr int NTHREADS = 512;
constexpr float ALPHA = 1.41421356237309515f;
constexpr float LN_EPS = 1e-5f;
constexpr float MASKV = -1e30f;

constexpr int C_AQ = 0, C_AK = 384, C_AV = 768, C_BQ = 1152, C_BF = 1664, C_BI = 2176, C_BG = 2560, C_CQ = 2944, C_CK = 3200, C_CV = 3328;

constexpr size_t al256(size_t x) { return (x + 255) & ~(size_t)255; }
constexpr size_t MB = 1048576;
constexpr size_t WS_CTL = 0, CTL_BYTES = 65536;
constexpr size_t CTL_COUNT_OFF = 16384;
constexpr size_t WS_OBUF = WS_CTL + CTL_BYTES;
constexpr size_t WS_H1 = WS_OBUF + 64 * MB;
constexpr size_t WS_HCUR = WS_H1 + 128 * MB;
constexpr size_t WS_GATE = WS_HCUR + 128 * MB;
constexpr size_t WS_LIST = WS_GATE + 1 * MB;
constexpr size_t WS_RDST = WS_LIST + 32 * MB;
constexpr size_t WS_RGATE = WS_RDST + 34 * MB;
constexpr size_t WS_HB = WS_RGATE + 34 * MB;
constexpr size_t WS_H1B = WS_HB + 64 * MB;
constexpr size_t WS_H1L = WS_H1B + 64 * MB;
constexpr size_t WS_WGU = WS_H1L + 64 * MB;
constexpr size_t WS_WD = WS_WGU + 257 * MB;
constexpr size_t WS_WIN = WS_WD + 257 * MB / 2 + MB / 2;
constexpr size_t WS_WOUT = WS_WIN + 14 * MB;
constexpr size_t WS_R1 = WS_WOUT + 4 * MB;
constexpr size_t WS_QKV = WS_R1;
constexpr size_t WS_AO = WS_QKV + 216 * MB;
constexpr size_t WS_LSE = WS_AO + 144 * MB;
constexpr size_t WS_BRAW = WS_LSE + 3 * MB;
constexpr size_t WS_QG = WS_BRAW + 48 * MB;
constexpr size_t WS_SG = WS_QG + 32 * MB;
constexpr size_t WS_DG = WS_SG + 12 * MB;
constexpr size_t WS_MIX = WS_R1;
constexpr size_t WS_LOGITS = WS_R1 + 128 * MB;
constexpr int MAXTILES = 1280 + 128;
constexpr size_t WS_HBUF = WS_R1;
constexpr size_t WS_SLOTS = WS_HBUF + 176 * MB;
constexpr size_t WS_END = WS_SLOTS + 576 * MB;
static_assert(WS_DG + MB <= WS_END, "ws");
static_assert(WS_END <= (size_t)2048 * MB, "ws too big");

constexpr int LDS_HDR = 2048;
constexpr int LDS_PREFIX = 64;
constexpr int LDS_BYTES = 159744;

struct Params {
    const float* x; const float* w_in; const float* w_out; const float* rel; const float* lbl; const float* hg; const float* sinks;
    const float* ln1g; const float* ln1b; const float* rw; const float* rb; const float* wg; const float* wu; const float* wd;
    const float* sg; const float* su; const float* sd; const float* ln2g; const float* ln2b;
    float* out; char* ws;
};

__device__ __forceinline__ unsigned pack2(float a, float b) { bf16x2_t p = __builtin_convertvector((f32x2){a, b}, bf16x2_t); return __builtin_bit_cast(unsigned, p); }
__device__ __forceinline__ u16 f2bf(float a) { __bf16 h = (__bf16)a; return __builtin_bit_cast(u16, h); }
__device__ __forceinline__ float bf2f(u16 v) { return __uint_as_float(((unsigned)v) << 16); }
__device__ __forceinline__ float bfround(float a) { return bf2f(f2bf(a)); }
__device__ __forceinline__ float rmax(float a, float b) { float r; asm("v_max_f32 %0, %1, %2" : "=v"(r) : "v"(a), "v"(b)); return r; }
__device__ __forceinline__ float rmin(float a, float b) { float r; asm("v_min_f32 %0, %1, %2" : "=v"(r) : "v"(a), "v"(b)); return r; }
__device__ __forceinline__ float sigmoidf_(float x) { return 1.0f / (1.0f + __expf(-x)); }
__device__ __forceinline__ float fsigmoid(float x) { return __builtin_amdgcn_rcpf(1.0f + __builtin_amdgcn_exp2f(x * -1.44269504088896341f)); }

template <int CTRL> __device__ __forceinline__ float dpp_f(float v) { return __int_as_float(__builtin_amdgcn_update_dpp(__float_as_int(v), __float_as_int(v), CTRL, 0xF, 0xF, true)); }
template <int O> __device__ __forceinline__ float xshfl(float v) {
    if constexpr (O == 1) return __int_as_float(__builtin_amdgcn_update_dpp(__float_as_int(v), __float_as_int(v), 0xB1, 0xF, 0xF, true));
    else if constexpr (O == 2) return __int_as_float(__builtin_amdgcn_update_dpp(__float_as_int(v), __float_as_int(v), 0x4E, 0xF, 0xF, true));
    else if constexpr (O == 16) { auto r = __builtin_amdgcn_permlane16_swap(__float_as_uint(v), __float_as_uint(v), false, false); return __uint_as_float(r[0] ^ r[1] ^ __float_as_uint(v)); }
    else if constexpr (O == 32) { auto r = __builtin_amdgcn_permlane32_swap(__float_as_uint(v), __float_as_uint(v), false, false); return __uint_as_float(r[0] ^ r[1] ^ __float_as_uint(v)); }
    else return __int_as_float(__builtin_amdgcn_ds_swizzle(__float_as_int(v), (O << 10) | 0x1F));
}
template <int O> __device__ __forceinline__ int xshfl_i(int v) { return __float_as_int(xshfl<O>(__int_as_float(v))); }
__device__ __forceinline__ float wave_sum(float v) {
    v += xshfl<1>(v); v += xshfl<2>(v); v += dpp_f<0x141>(v); v += dpp_f<0x140>(v); v += xshfl<16>(v); v += xshfl<32>(v);
    return v;
}

extern __shared__ __attribute__((aligned(16))) char smem[];
__device__ __forceinline__ int tid_opaque() { int t = threadIdx.x; asm volatile("" : "+v"(t)); return t; }

constexpr int G_ASTR = 144, G_BSTR = 320;
constexpr int G_ABYTES = 256 * G_ASTR, G_BBYTES = 64 * G_BSTR, G_STAGE = G_ABYTES + G_BBYTES;
static_assert(LDS_HDR + 2 * G_STAGE <= LDS_BYTES, "lds");

template <int SPLIT, class AOff, class BPtr, class Epi>
__device__ __forceinline__ void gemm_tile(const u16* Ahi, const u16* Alo, int K, int ldb, AOff aoff, BPtr bptr, Epi epi) {
    const int t = tid_opaque(), lane = t & 63, wave = t >> 6, wr = wave >> 1, wc = wave & 1;
    const int nk = K >> 6, nsteps = SPLIT ? 3 * nk : nk;
    unsigned aoffs[4];
#pragma unroll
    for (int i = 0; i < 4; ++i) aoffs[i] = aoff((t >> 3) + 64 * i) + (t & 7) * 8;
    const float* bp = bptr((t & 31) * 4) + (size_t)(t >> 5) * ldb;
    uint4 rab[4]; f32x4 rb[4];
    auto gload = [&](int step) {
        const int kt = SPLIT ? (step % nk) : step;
        const u16* Ab = (SPLIT && step >= 2 * nk) ? Alo : Ahi;
#pragma unroll
        for (int i = 0; i < 4; ++i) rab[i] = *(const uint4*)(Ab + aoffs[i] + kt * 64);
#pragma unroll
        for (int i = 0; i < 4; ++i) rb[i] = *(const f32x4*)(bp + (size_t)(kt * 64 + 16 * i) * ldb);
    };
    auto lwrite = [&](int step, int buf) {
        const bool blo = SPLIT && (step >= nk) && (step < 2 * nk);
        const int ab = LDS_HDR + buf * G_STAGE, bb = ab + G_ABYTES;
#pragma unroll
        for (int i = 0; i < 4; ++i) *(uint4*)(smem + ab + ((t >> 3) + 64 * i) * G_ASTR + (t & 7) * 16) = rab[i];
#pragma unroll
        for (int i = 0; i < 4; ++i) {
            f32x4 v = rb[i];
            if (blo) { v[0] -= bfround(v[0]); v[1] -= bfround(v[1]); v[2] -= bfround(v[2]); v[3] -= bfround(v[3]); }
            uint2 p; p.x = pack2(v[0], v[1]); p.y = pack2(v[2], v[3]);
            *(uint2*)(smem + bb + ((t >> 5) + 16 * i) * G_BSTR + (t & 31) * 8) = p;
        }
    };
    f32x16 acc[2][2];
#pragma unroll
    for (int m = 0; m < 2; ++m)
#pragma unroll
        for (int n = 0; n < 2; ++n)
#pragma unroll
            for (int r = 0; r < 16; ++r) acc[m][n][r] = 0.f;
    const int a_rd = (wr * 64 + (lane & 31)) * G_ASTR + (lane >> 5) * 16;
    const int b_rd = ((lane >> 5) * 8 + ((lane & 15) >> 2)) * G_BSTR + (wc * 64 + 16 * ((lane >> 4) & 1) + 4 * (lane & 3)) * 2;
    gload(0);
    lwrite(0, 0);
    __syncthreads();
    for (int s = 0; s < nsteps; ++s) {
        const int buf = s & 1;
        if (s + 1 < nsteps) gload(s + 1);
        const int ab = LDS_HDR + buf * G_STAGE, bb = ab + G_ABYTES;
#pragma unroll
        for (int kk = 0; kk < 4; ++kk) {
            s16x8 af[2], bf[2];
#pragma unroll
            for (int m = 0; m < 2; ++m) af[m] = *(const s16x8*)(smem + ab + a_rd + m * 32 * G_ASTR + kk * 32);
#pragma unroll
            for (int n = 0; n < 2; ++n) {
                const int o = bb + b_rd + kk * 16 * G_BSTR + n * 64;
                s16x4 lo = __builtin_amdgcn_ds_read_tr16_b64_v4i16((LAS s16x4*)(smem + o));
                s16x4 hi = __builtin_amdgcn_ds_read_tr16_b64_v4i16((LAS s16x4*)(smem + o + 4 * G_BSTR));
                bf[n] = (s16x8){lo[0], lo[1], lo[2], lo[3], hi[0], hi[1], hi[2], hi[3]};
            }
#pragma unroll
            for (int m = 0; m < 2; ++m)
#pragma unroll
                for (int n = 0; n < 2; ++n) acc[m][n] = __builtin_amdgcn_mfma_f32_32x32x16_bf16(af[m], bf[n], acc[m][n], 0, 0, 0);
        }
        if (s + 1 < nsteps) lwrite(s + 1, buf ^ 1);
        __syncthreads();
    }
    epi(acc, wr, wc, lane);
}
#define CROW(m, r) (wr * 64 + (m) * 32 + ((r) & 3) + 8 * ((r) >> 2) + 4 * (lane >> 5))
#define CCOL(n) (wc * 64 + (n) * 32 + (lane & 31))

namespace eg {
constexpr int BM = 256, BK = 64, HALF = 128, HTB = HALF * BK * 2, STAGE_BYTES = 8 * HTB, NXCD = 8, WGM = 8;
static_assert(LDS_HDR + STAGE_BYTES <= LDS_BYTES, "lds eg");
__device__ __forceinline__ int lds_byte(int r, int c) { const int st = (r >> 4) * 2 + (c >> 5), rr = r & 15, cc = c & 31, ob = rr * 64 + cc * 2; return st * 1024 + (ob ^ (((ob >> 9) & 1) << 5)); }
__device__ __forceinline__ void stage_rc(int b, int& R, int& C) { const int st = b / 1024, sb = b % 1024, swz = sb ^ (((sb >> 9) & 1) << 5); R = (st >> 1) * 16 + swz / 64; C = (st & 1) * 32 + (swz % 64) / 2; }
typedef short bf16x8 __attribute__((ext_vector_type(8)));

__device__ __forceinline__ int perm32(int rho) { const int n = rho >> 4, i = rho & 15; return 8 * (i >> 2) + 4 * n + (i & 3); }
__device__ __forceinline__ int perm64(int R) { return 64 * (R >> 5) + 16 * ((R >> 2) & 3) + 4 * ((R >> 4) & 1) + (R & 3); }
constexpr int EG_RI = LDS_HDR + STAGE_BYTES;
constexpr int EG_TAB = EG_RI + 4096;
constexpr int EG_EPB = EG_TAB + 1408 * 4;
static_assert(EG_EPB + 16384 <= LDS_BYTES, "lds ri");
typedef int i32x8 __attribute__((ext_vector_type(8)));
__device__ __forceinline__ void stage_rc8(int b, int& R, int& Cb) {
    const int h = b >> 13, r = (b >> 6) & 127, cp = (b >> 4) & 3;
    const int p = (0x78 >> (2 * (cp ^ ((r >> 2) & 3)))) & 3;
    R = r; Cb = p * 32 + h * 16;
}
template <int PERM, bool FP8, int NST, class Sched, class Epi>
__device__ __forceinline__ void gemm_stream(int Kb, int ldaB, const Sched& S, const Epi& E) {
    typedef typename Sched::Unit Unit;
    LAS unsigned char* lds = (LAS unsigned char*)(smem + LDS_HDR);
    const int tid = tid_opaque(), wid = __builtin_amdgcn_readfirstlane(tid >> 6), lane = tid & 63, wr = wid >> 2, wc = wid & 3, fr = lane & 15, fq = lane >> 4;
    const int nt = Kb / 128;
    unsigned voffB[2]; unsigned vA0[2], vA1[2];
    Unit cur, nxt; int ui = 0;
    if (!S.next(0, cur)) return;
    auto stage_map = [&](int b, int& R, int& Cb) __attribute__((always_inline)) { if (FP8) stage_rc8(b, R, Cb); else { int C; stage_rc(b, R, C); Cb = C * 2; } };
    { int R0, C0, R1, C1; stage_map(tid * 16, R0, C0); stage_map(tid * 16 + 8192, R1, C1);
      vA0[0] = (unsigned)S.arow(cur, R0) * (unsigned)ldaB + C0; vA0[1] = (unsigned)S.arow(cur, R1) * (unsigned)ldaB + C1;
      if (Sched::DENSE_A) { vA1[0] = vA0[0]; vA1[1] = vA0[1]; }
      else { vA1[0] = (unsigned)S.arow(cur, 128 + R0) * (unsigned)ldaB + C0; vA1[1] = (unsigned)S.arow(cur, 128 + R1) * (unsigned)ldaB + C1; }
      const int Rb0 = PERM == 2 ? perm64(R0) : (PERM ? ((R0 & ~31) + perm32(R0 & 31)) : R0), Rb1 = PERM == 2 ? perm64(R1) : (PERM ? ((R1 & ~31) + perm32(R1 & 31)) : R1);
      voffB[0] = (unsigned)(Rb0 * Kb + C0); voffB[1] = (unsigned)(Rb1 * Kb + C1); }
    const size_t kstep = 128;
    const size_t hstep = (size_t)(PERM == 2 ? 8 : HALF) * Kb;
    const size_t hstepA = Sched::DENSE_A ? (size_t)HALF * ldaB : 0;
    const unsigned ldsw = (unsigned)wid * 1024u;
    const int gq = (0x9C >> (2 * fq)) & 3;
    const int aoff = FP8 ? ((wr * 64 + fr) * 64 + ((((fr >> 2) & 3) ^ gq) << 4)) : lds_byte(wr * 64 + fr, fq * 8);
    const int boff = FP8 ? ((wc * 32 + fr) * 64 + ((((fr >> 2) & 3) ^ gq) << 4)) : lds_byte(wc * 32 + fr, fq * 8);
    const unsigned lda2 = (unsigned)ldaB;
#define EG_SA(b, h) (((b) * 2 + (h)) * HTB)
#define EG_SB(b, h) ((4 + (b) * 2 + (h)) * HTB)
#define EG_STAGE(bufoff, gbase, voff) do { _Pragma("unroll") for (int _i = 0; _i < 2; ++_i) \
        __builtin_amdgcn_global_load_lds((const unsigned*)((const char*)(gbase) + (voff)[_i]), (LAS unsigned*)(lds + (bufoff) + ldsw + _i * 8192), 16, 0, 0); } while (0)
#define EG_LDA(dst, b, h) do { if constexpr (FP8) { _Pragma("unroll") for (int m = 0; m < 4; ++m) { const u32x4 l0_ = *(const LAS u32x4*)(lds + EG_SA(b, h) + aoff + m * 1024), l1_ = *(const LAS u32x4*)(lds + EG_SA(b, h) + aoff + m * 1024 + 8192); \
            dst##8[m] = __builtin_bit_cast(i32x8, __builtin_shufflevector(l0_, l1_, 0, 1, 2, 3, 4, 5, 6, 7)); } } \
        else { _Pragma("unroll") for (int m = 0; m < 4; ++m) _Pragma("unroll") for (int k = 0; k < 2; ++k) dst[m][k] = *(const LAS bf16x8*)(lds + EG_SA(b, h) + aoff + m * 2048 + k * 1024); } } while (0)
#define EG_LDB(dst, b, h) do { if constexpr (FP8) { _Pragma("unroll") for (int n = 0; n < 2; ++n) { const u32x4 l0_ = *(const LAS u32x4*)(lds + EG_SB(b, h) + boff + n * 1024), l1_ = *(const LAS u32x4*)(lds + EG_SB(b, h) + boff + n * 1024 + 8192); \
            dst##8[n] = __builtin_bit_cast(i32x8, __builtin_shufflevector(l0_, l1_, 0, 1, 2, 3, 4, 5, 6, 7)); } } \
        else { _Pragma("unroll") for (int n = 0; n < 2; ++n) _Pragma("unroll") for (int k = 0; k < 2; ++k) dst[n][k] = *(const LAS bf16x8*)(lds + EG_SB(b, h) + boff + n * 2048 + k * 1024); } } while (0)
#define EG_MMA(ai, bj, At, Bt) do { __builtin_amdgcn_s_setprio(1); if constexpr (FP8) { _Pragma("unroll") for (int m = 0; m < 4; ++m) _Pragma("unroll") for (int n = 0; n < 2; ++n) \
            acc[ai][bj][m][n] = __builtin_amdgcn_mfma_scale_f32_16x16x128_f8f6f4(Bt##8[n], At##8[m], acc[ai][bj][m][n], 0, 0, 0, 0, 0, 0); } \
        else { _Pragma("unroll") for (int m = 0; m < 4; ++m) _Pragma("unroll") for (int n = 0; n < 2; ++n) _Pragma("unroll") for (int k = 0; k < 2; ++k) \
            acc[ai][bj][m][n] = __builtin_amdgcn_mfma_f32_16x16x32_bf16(Bt[n][k], At[m][k], acc[ai][bj][m][n], 0, 0, 0); } __builtin_amdgcn_s_setprio(0); } while (0)
#define EG_WAIT_V(n) asm volatile("s_waitcnt vmcnt(" #n ")" ::: "memory")
#define EG_WAIT_L(n) asm volatile("s_waitcnt lgkmcnt(" #n ")" ::: "memory")
#define EG_WAIT_VR() do { if (NST > 0 && relax) asm volatile("s_waitcnt vmcnt(%0)" :: "n"(8 + NST + Sched::BEGIN_OPS) : "memory"); else asm volatile("s_waitcnt vmcnt(8)" ::: "memory"); } while (0)
#define EG_BAR __builtin_amdgcn_s_barrier()
#define EG_SCHED __builtin_amdgcn_sched_barrier(0)
    f32x4 acc[2][2][4][2];
#pragma unroll
    for (int a = 0; a < 2; ++a)
#pragma unroll
        for (int b = 0; b < 2; ++b)
#pragma unroll
            for (int m = 0; m < 4; ++m)
#pragma unroll
                for (int n = 0; n < 2; ++n) acc[a][b][m][n] = (f32x4){0.f, 0.f, 0.f, 0.f};
    bf16x8 At[4][2], B0[2][2], B1[2][2]; i32x8 At8[4], B08[2], B18[2];
    const char* cA = cur.A; const char* cB = cur.B;
    S.begin(cur, (LAS unsigned*)(smem + EG_RI), tid);
    EG_STAGE(EG_SB(0, 0), cB, voffB); EG_STAGE(EG_SB(0, 1), cB + hstep, voffB); EG_STAGE(EG_SA(0, 0), cA, vA0); EG_STAGE(EG_SA(0, 1), cA + hstepA, vA1);
    if (wr == 1) EG_BAR;
    EG_WAIT_V(2); EG_BAR;
    EG_STAGE(EG_SB(1, 0), cB + kstep, voffB); EG_STAGE(EG_SA(1, 0), cA + kstep, vA0); EG_STAGE(EG_SB(1, 1), cB + hstep + kstep, voffB);
    EG_WAIT_V(6); EG_BAR;
    for (;;) {
        const bool has_next = S.next(ui + 1, nxt);
        const char* nA = has_next ? nxt.A : cA; const char* nB = has_next ? nxt.B : cB;
        if (has_next) S.prefetch_rows(nxt, (LAS unsigned*)(smem + EG_RI + ((ui + 1) & 1) * 2048), tid);
#pragma unroll 1
        for (int t = 0; t < nt; t += 2) {
            const bool last = (t == nt - 2);
            const bool relax = (t == 0) && (ui > 0);
            const char* a1 = cA + (size_t)(t + 1) * kstep;
            const char* a2 = last ? nA : cA + (size_t)(t + 2) * kstep; const char* b2 = last ? nB : cB + (size_t)(t + 2) * kstep;
            const char* a3 = a2 + kstep; const char* b3 = b2 + kstep;
            EG_LDB(B0, 0, 0); EG_LDB(B1, 0, 1); EG_SCHED; EG_LDA(At, 0, 0); EG_STAGE(EG_SA(1, 1), a1 + hstepA, vA1);
            if (last && has_next) {
                int r0, c0, r1, c1; stage_map(tid * 16, r0, c0); stage_map(tid * 16 + 8192, r1, c1);
                const LAS unsigned* rl = (const LAS unsigned*)(smem + EG_RI + ((ui + 1) & 1) * 2048);
                vA0[0] = (unsigned)S.arow_lds(nxt, r0, rl) * lda2 + c0; vA0[1] = (unsigned)S.arow_lds(nxt, r1, rl) * lda2 + c1;
                if (Sched::DENSE_A) { vA1[0] = vA0[0]; vA1[1] = vA0[1]; }
                else { vA1[0] = (unsigned)S.arow_lds(nxt, 128 + r0, rl) * lda2 + c0; vA1[1] = (unsigned)S.arow_lds(nxt, 128 + r1, rl) * lda2 + c1; }
            }
            EG_WAIT_VR(); EG_WAIT_L(0); EG_BAR; EG_MMA(0, 0, At, B0); EG_MMA(0, 1, At, B1); EG_BAR; EG_SCHED;
            EG_LDA(At, 0, 1); EG_STAGE(EG_SB(0, 0), b2, voffB); EG_STAGE(EG_SB(0, 1), b2 + hstep, voffB); EG_STAGE(EG_SA(0, 0), a2, vA0);
            EG_WAIT_VR(); EG_WAIT_L(0); EG_BAR; if (!cur.half) { EG_MMA(1, 0, At, B0); EG_MMA(1, 1, At, B1); } EG_BAR; EG_SCHED;
            EG_LDB(B0, 1, 0); EG_LDB(B1, 1, 1); EG_SCHED; EG_LDA(At, 1, 0); EG_STAGE(EG_SA(0, 1), a2 + hstepA, vA1);
            EG_WAIT_V(8); EG_WAIT_L(0); EG_BAR; EG_MMA(0, 0, At, B0); EG_MMA(0, 1, At, B1); EG_BAR; EG_SCHED;
            EG_LDA(At, 1, 1); EG_STAGE(EG_SB(1, 0), b3, voffB); EG_STAGE(EG_SB(1, 1), b3 + hstep, voffB); EG_STAGE(EG_SA(1, 0), a3, vA0);
            EG_WAIT_V(8); EG_WAIT_L(0); EG_BAR; if (!cur.half) { EG_MMA(1, 0, At, B0); EG_MMA(1, 1, At, B1); } EG_BAR; EG_SCHED;
        }
        if (wr == 0) EG_BAR;
        E(acc, cur, wr, wc, fr, fq, (const LAS unsigned*)(smem + EG_RI + (ui & 1) * 2048));
        if (!has_next) break;
#pragma unroll
        for (int a = 0; a < 2; ++a)
#pragma unroll
            for (int b = 0; b < 2; ++b)
#pragma unroll
                for (int m = 0; m < 4; ++m)
#pragma unroll
                    for (int n = 0; n < 2; ++n) acc[a][b][m][n] = (f32x4){0.f, 0.f, 0.f, 0.f};
        cur = nxt; cA = nA; cB = nB; ++ui;
        S.begin(cur, (LAS unsigned*)(smem + EG_RI + (ui & 1) * 2048), tid);
        if (wr == 1) EG_BAR;
    }
    EG_WAIT_V(0);
    EG_BAR;
#undef EG_SA
#undef EG_SB
#undef EG_STAGE
#undef EG_LDA
#undef EG_LDB
#undef EG_MMA
#undef EG_WAIT_V
#undef EG_WAIT_L
#undef EG_WAIT_VR
#undef EG_BAR
#undef EG_SCHED
}

struct DenseUnit { const char* A; const char* B; int pm, pn; bool half; };
struct DenseSched {
    typedef DenseUnit Unit;
    static constexpr bool DENSE_A = true;
    static constexpr int BEGIN_OPS = 0;
    const char* A; const char* Bt; int K, nM, nN, nwg, G, c;
    __device__ __forceinline__ bool next(int i, Unit& u) const {
        const long L = (long)i * G + c; if (L >= nwg) return false;
        int wgid = (int)L; { const int q = nwg / NXCD, r = nwg % NXCD, xcd = wgid % NXCD, off = wgid / NXCD; wgid = (xcd < r ? xcd * (q + 1) : r * (q + 1) + (xcd - r) * q) + off; }
        const int nig = WGM * nN, gid = wgid / nig, fm = gid * WGM, gsz = (nM - fm) < WGM ? (nM - fm) : WGM;
        u.pm = fm + ((wgid % nig) % gsz); u.pn = (wgid % nig) / gsz;
        u.A = A; u.B = Bt + (size_t)u.pn * 256 * K * 2; u.half = false;
        return true;
    }
    __device__ __forceinline__ int arow(const Unit& u, int r) const { return u.pm * 256 + r; }
    __device__ __forceinline__ int arow_lds(const Unit& u, int r, const LAS unsigned*) const { return u.pm * 256 + r; }
    __device__ __forceinline__ void prefetch_rows(const Unit&, LAS unsigned*, int) const {}
    __device__ __forceinline__ void begin(const Unit&, LAS unsigned*, int) const {}
};

struct MoeUnit { const char* A; const char* B; int e, mt, cnt, tile, sub; bool half; };
template <int SUB, bool GATHER, bool ROWINFO>
struct MoeSched {
    typedef MoeUnit Unit;
    static constexpr bool DENSE_A = !GATHER;
    static constexpr int BEGIN_OPS = ROWINFO ? 1 : 0;
    const char* A; const char* W; const int* lst; const int* cnts; const int* gcum; const unsigned* rdst; int ntiles, G, c; size_t wstride_e, wstride_sub; int abytes;
    __device__ __forceinline__ bool next(int i, Unit& u) const {
        int tile, sub;
        if (G % (8 * SUB) == 0) { const int q = c & 7, j = c >> 3, per = G / (8 * SUB); tile = i * (G / SUB) + q * per + (j / SUB); sub = j % SUB; }
        else { const int L = i * G + c; tile = L / SUB; sub = L % SUB; }
        if (tile >= ntiles + 128) return false;
        u.tile = tile; u.sub = sub;
        if (tile < ntiles) {
            const unsigned pk = ((const unsigned*)(smem + EG_TAB))[tile];
            u.e = (int)(pk & 511u); u.mt = (int)((pk >> 9) & 127u); u.cnt = (int)(pk >> 16);
        } else { u.e = 256; u.mt = tile - ntiles; u.cnt = 256; }
        u.half = u.cnt <= 128;
        u.A = GATHER ? A : A + (size_t)tile * (size_t)abytes;
        u.B = W + (size_t)u.e * wstride_e + (size_t)u.sub * wstride_sub;
        return true;
    }
    __device__ __forceinline__ int arow(const Unit& u, int r) const {
        if (!GATHER) return r;
        if (u.e == 256) return u.mt * 256 + r;
        return r < u.cnt ? (lst[(size_t)u.e * T + u.mt * 256 + r] >> 3) : 0;
    }
    __device__ __forceinline__ int arow_lds(const Unit& u, int r, const LAS unsigned* rl) const {
        if (!GATHER) return r;
        if (u.e == 256) return u.mt * 256 + r;
        return r < u.cnt ? (int)(rl[r] >> 3) : 0;
    }
    __device__ __forceinline__ void prefetch_rows(const Unit& u, LAS unsigned* rl, int) const {
        const int tid = tid_opaque();
        if (GATHER && !ROWINFO) { if (tid < 256) __builtin_amdgcn_global_load_lds((const unsigned*)lst + (size_t)(u.e == 256 ? 0 : u.e) * T + u.mt * 256 + tid, rl + (tid & ~63), 4, 0, 0); }
    }
    __device__ __forceinline__ void begin(const Unit& u, LAS unsigned* ri, int) const {
        if (ROWINFO) {
            const int tid = tid_opaque();
            const unsigned* srcp = rdst + (size_t)(tid >> 8) * ((WS_RGATE - WS_RDST) / 4) + (size_t)u.e * T + u.mt * 256 + (tid & 255);
            __builtin_amdgcn_global_load_lds(srcp, ri + (tid & ~63), 4, 0, 0);
        }
    }
};
}

constexpr int CV_STR = 144;
template <class DstRow>
__device__ __forceinline__ void conv_block(const float* src, int ldsrc, int k0, int n0, u16* dst, DstRow dstrow) {
    const int t = tid_opaque();
#pragma unroll
    for (int i = 0; i < 4; ++i) {
        const int k = (t >> 5) + 16 * i, nq = t & 31;
        const f32x4 v = *(const f32x4*)(src + (size_t)(k0 + k) * ldsrc + n0 + nq * 4);
#pragma unroll
        for (int j = 0; j < 4; ++j) *(u16*)(smem + LDS_HDR + (nq * 4 + j) * CV_STR + k * 2) = f2bf(v[j]);
    }
    __syncthreads();
#pragma unroll
    for (int i = 0; i < 2; ++i) {
        const int n = (t >> 3) + 64 * i, c = t & 7;
        *(u32x4*)(dst + dstrow(n0 + n) + k0 + c * 8) = *(const u32x4*)(smem + LDS_HDR + n * CV_STR + c * 16);
    }
    __syncthreads();
}

struct CvDesc { const float* src; u16* dst; int ld, rs_hi, radd, dk; bool f8; };
template <class GetDesc>
__device__ __forceinline__ void conv_stream(int nblocks, int first, int stride, GetDesc getdesc) {
    const int t = tid_opaque(), kb = 8 * (t >> 6), nq = t & 63;
    if (first >= nblocks) return;
    constexpr int CVB = 256 * 128;
    CvDesc d[2]; f32x4 r[2][8]; bool hv[2];
#pragma unroll
    for (int b = 0; b < 2; ++b) {
        const int u = first + b * stride; hv[b] = u < nblocks; d[b] = getdesc(hv[b] ? u : first);
#pragma unroll
        for (int i = 0; i < 8; ++i) r[b][i] = *(const f32x4*)(d[b].src + (size_t)(kb + i) * d[b].ld + nq * 4);
    }
    for (int u0 = first; u0 < nblocks; u0 += 2 * stride) {
        CvDesc dn[2]; f32x4 rn[2][8]; bool hn[2];
#pragma unroll
        for (int b = 0; b < 2; ++b) {
            const int u = u0 + (2 + b) * stride; hn[b] = u < nblocks; dn[b] = getdesc(hn[b] ? u : first);
            if (hn[b]) {
#pragma unroll
                for (int i = 0; i < 8; ++i) rn[b][i] = *(const f32x4*)(dn[b].src + (size_t)(kb + i) * dn[b].ld + nq * 4);
            }
        }
#pragma unroll
        for (int b = 0; b < 2; ++b)
#pragma unroll
            for (int j = 0; j < 4; ++j) {
                u32x4 p; p[0] = pack2(r[b][0][j], r[b][1][j]); p[1] = pack2(r[b][2][j], r[b][3][j]); p[2] = pack2(r[b][4][j], r[b][5][j]); p[3] = pack2(r[b][6][j], r[b][7][j]);
                *(u32x4*)(smem + LDS_HDR + b * CVB + (nq * 4 + j) * 128 + (((t >> 6) ^ (nq & 7)) << 4)) = p;
            }
        __syncthreads();
#pragma unroll
        for (int b = 0; b < 2; ++b) {
            if (hv[b]) {
#pragma unroll
                for (int i = 0; i < 4; ++i) {
                    const int n = (t >> 3) + 64 * i, c = t & 7;
                    *(u32x4*)(d[b].dst + (size_t)((n >> 7) * d[b].rs_hi + d[b].radd + (n & 127)) * d[b].dk + c * 8) = *(const u32x4*)(smem + LDS_HDR + b * CVB + n * 128 + ((c ^ ((n >> 2) & 7)) << 4));
                }
            }
        }
        __syncthreads();
#pragma unroll
        for (int b = 0; b < 2; ++b) {
            d[b] = dn[b]; hv[b] = hn[b];
#pragma unroll
            for (int i = 0; i < 8; ++i) r[b][i] = rn[b][i];
        }
    }
}

template <class GetDesc>
__device__ __forceinline__ void conv_stream_dyn(int nblocks, unsigned* ctr, GetDesc getdesc) {
    const int t = tid_opaque(), kb = 8 * (t >> 6), nq = t & 63;
    constexpr int CVB = 256 * 128;
    volatile int* idxs = (volatile int*)(smem + 32);
    if (t == 0) { idxs[0] = (int)atomicAdd(ctr, 2u); idxs[1] = (int)atomicAdd(ctr, 2u); }
    __syncthreads();
    int cur = idxs[0], nxt = idxs[1];
    __syncthreads();
    if (cur >= nblocks) return;
    CvDesc d[2]; f32x4 r[2][8]; bool hv[2];
#pragma unroll
    for (int b = 0; b < 2; ++b) {
        const int u = cur + b; hv[b] = u < nblocks; d[b] = getdesc(hv[b] ? u : cur);
#pragma unroll
        for (int i = 0; i < 8; ++i) r[b][i] = *(const f32x4*)(d[b].src + (size_t)(kb + i) * d[b].ld + nq * 4);
    }
    for (int k = 0; cur < nblocks; ++k) {
        if (t == 0) idxs[k & 1] = (int)atomicAdd(ctr, 2u);
        CvDesc dn[2]; f32x4 rn[2][8]; bool hn[2];
#pragma unroll
        for (int b = 0; b < 2; ++b) {
            const int u = nxt + b; hn[b] = u < nblocks; dn[b] = getdesc(hn[b] ? u : cur);
            if (hn[b]) {
#pragma unroll
                for (int i = 0; i < 8; ++i) rn[b][i] = *(const f32x4*)(dn[b].src + (size_t)(kb + i) * dn[b].ld + nq * 4);
            }
        }
#pragma unroll
        for (int b = 0; b < 2; ++b) {
            if (d[b].f8) {
#pragma unroll
                for (int jj = 0; jj < 4; ++jj) {
                    u32x2 p;
                    p[0] = (unsigned)__builtin_amdgcn_cvt_pk_fp8_f32(64.f * r[b][2][jj], 64.f * r[b][3][jj], __builtin_amdgcn_cvt_pk_fp8_f32(64.f * r[b][0][jj], 64.f * r[b][1][jj], 0, false), true);
                    p[1] = (unsigned)__builtin_amdgcn_cvt_pk_fp8_f32(64.f * r[b][6][jj], 64.f * r[b][7][jj], __builtin_amdgcn_cvt_pk_fp8_f32(64.f * r[b][4][jj], 64.f * r[b][5][jj], 0, false), true);
                    *(u32x2*)(smem + LDS_HDR + b * CVB + (nq * 4 + jj) * 64 + (((t >> 6) ^ (nq & 7)) << 3)) = p;
                }
            } else {
#pragma unroll
                for (int jj = 0; jj < 4; ++jj) {
                    u32x4 p; p[0] = pack2(r[b][0][jj], r[b][1][jj]); p[1] = pack2(r[b][2][jj], r[b][3][jj]); p[2] = pack2(r[b][4][jj], r[b][5][jj]); p[3] = pack2(r[b][6][jj], r[b][7][jj]);
                    *(u32x4*)(smem + LDS_HDR + b * CVB + (nq * 4 + jj) * 128 + (((t >> 6) ^ (nq & 7)) << 4)) = p;
                }
            }
        }
        __syncthreads();
#pragma unroll
        for (int b = 0; b < 2; ++b) {
            if (hv[b]) {
                if (d[b].f8) {
#pragma unroll
                    for (int i = 0; i < 2; ++i) {
                        const int idx = t + NTHREADS * i, n = idx >> 2, c = idx & 3, sw = (n >> 2) & 7;
                        const u32x2 lo = *(const u32x2*)(smem + LDS_HDR + b * CVB + n * 64 + (((2 * c) ^ sw) << 3)), hi = *(const u32x2*)(smem + LDS_HDR + b * CVB + n * 64 + (((2 * c + 1) ^ sw) << 3));
                        *(u32x4*)((unsigned char*)d[b].dst + (size_t)((n >> 7) * d[b].rs_hi + d[b].radd + (n & 127)) * d[b].dk + c * 16) = (u32x4){lo[0], lo[1], hi[0], hi[1]};
                    }
                } else {
#pragma unroll
                    for (int i = 0; i < 4; ++i) {
                        const int n = (t >> 3) + 64 * i, c = t & 7;
                        *(u32x4*)(d[b].dst + (size_t)((n >> 7) * d[b].rs_hi + d[b].radd + (n & 127)) * d[b].dk + c * 8) = *(const u32x4*)(smem + LDS_HDR + b * CVB + n * 128 + ((c ^ ((n >> 2) & 7)) << 4));
                    }
                }
            }
        }
        __syncthreads();
        cur = nxt; nxt = idxs[k & 1];
#pragma unroll
        for (int b = 0; b < 2; ++b) {
            d[b] = dn[b]; hv[b] = hn[b];
#pragma unroll
            for (int i = 0; i < 8; ++i) r[b][i] = rn[b][i];
        }
    }
}

__device__ __forceinline__ int rel_bucket(int dist) {
    if (dist < 16) return dist;
    float lr = logf((float)dist / 16.0f) / 4.852030263919617f;
    int v = 16 + (int)(lr * 16.0f);
    return v < 31 ? v : 31;
}

constexpr int AT_BIAS = LDS_HDR, AT_Q = AT_BIAS + 1024, AT_QSTR = 144, AT_K = AT_Q + 128 * AT_QSTR, AT_V = AT_K + 256 * AT_QSTR, AT_VSTR = 192,
              AT_P = AT_V + 288 * AT_VSTR, AT_PSTR = 336, AT_END = AT_P + 8 * 16 * AT_PSTR;
static_assert(AT_END <= LDS_BYTES, "lds attn");

struct AUnit { int tok0, r, qb, qcol, kcol, vcol, maxd, relhead, pidx, head, mode; float sinkv; };
struct ARegs { u32x4 q[2], k[4], v[4]; float bias; };

template <int which>
__device__ __forceinline__ bool attn_decode(const Params& P, int l, int idx, AUnit& u) {
    if (which == 0) {
        if (idx >= 3072 + 1024) return false;
        if (idx < 3072) {
            const int p = 1 + idx / 1536, rem = idx % 1536, head = rem % 6, sb = rem / 6;
            const int r = (p == 1) ? 4 : 16, nblk = 64 / r;
            const int seq = sb / nblk, qb = sb % nblk, b = seq / r, res = seq % r;
            u.tok0 = b * SEQ + res; u.r = r; u.qb = qb; u.qcol = C_AQ + head * 64; u.kcol = C_AK + head * 64; u.vcol = C_AV + head * 64; u.maxd = 128; u.relhead = head;
            u.pidx = p - 1; u.head = head; u.mode = 0; u.sinkv = 0.f;
        } else {
            const int uc = idx - 3072, head = uc & 3, sb = uc >> 2, b = sb >> 6, qb = sb & 63;
            u.tok0 = b * SEQ; u.r = 1; u.qb = qb; u.qcol = C_CQ + head * 64; u.kcol = C_CK + (head >> 1) * 64; u.vcol = C_CV + (head >> 1) * 64; u.maxd = 127; u.relhead = 6 + head;
            u.pidx = 0; u.head = head; u.mode = 1; u.sinkv = P.sinks[l * 4 + head];
        }
    } else {
        if (idx >= 1536) return false;
        const int head = idx % 6, sb = idx / 6, b = sb >> 6, qb = sb & 63;
        u.tok0 = b * SEQ; u.r = 1; u.qb = qb; u.qcol = C_AQ + head * 64; u.kcol = C_AK + head * 64; u.vcol = C_AV + head * 64; u.maxd = 128; u.relhead = head;
        u.pidx = 0; u.head = head; u.mode = 2; u.sinkv = 0.f;
    }
    return true;
}

__device__ __forceinline__ void attn_gload(const Params& P, const AUnit& u, ARegs& R, int t) {
    const u16* qkv = (const u16*)(P.ws + WS_QKV);
    const int c = t & 7;
#pragma unroll
    for (int i = 0; i < 2; ++i) {
        const int row = (t >> 3) + 64 * i;
        const size_t tok = (size_t)u.tok0 + (size_t)u.r * (u.qb * 128 + row);
        R.q[i] = *(const u32x4*)(qkv + tok * INW + u.qcol + c * 8);
    }
#pragma unroll
    for (int i = 0; i < 4; ++i) {
        const int row = (t >> 3) + 64 * i;
        int pos = (u.qb - 1) * 128 + row; if (pos < 0) pos = row;
        const size_t tok = (size_t)u.tok0 + (size_t)u.r * pos;
        R.k[i] = *(const u32x4*)(qkv + tok * INW + u.kcol + c * 8);
        R.v[i] = *(const u32x4*)(qkv + tok * INW + u.vcol + c * 8);
    }
    { const int d = t < 129 ? t : 128; R.bias = P.rel[rel_bucket(d * u.r) * 10 + u.relhead] * 1.44269504088896341f; }
}
__device__ __forceinline__ void attn_lstore(const ARegs& R, int t) {
    const int c = t & 7;
#pragma unroll
    for (int i = 0; i < 2; ++i) *(u32x4*)(smem + AT_Q + ((t >> 3) + 64 * i) * AT_QSTR + c * 16) = R.q[i];
#pragma unroll
    for (int i = 0; i < 4; ++i) {
        const int row = (t >> 3) + 64 * i;
        *(u32x4*)(smem + AT_K + row * AT_QSTR + c * 16) = R.k[i];
        *(u32x4*)(smem + AT_V + row * AT_VSTR + c * 16) = R.v[i];
    }
    if (t < 132) ((float*)(smem + AT_BIAS))[t] = R.bias;
}

template <int which>
__device__ __forceinline__ void attn_compute(const Params& P, const AUnit& u, int t) {
    const int lane = t & 63, w = t >> 6, r = lane & 15, g = lane >> 4;
    const int qb = u.qb, maxd = u.maxd;
    const float sinkv = u.sinkv;
    const int mode = which == 1 ? 2 : u.mode;
    const bool has_sink = (mode == 1);
    const unsigned tokr = (unsigned)u.tok0 + (unsigned)u.r * (unsigned)(qb * 128 + 16 * w + r);
    u16* aob = (u16*)(P.ws + WS_AO);
    float* lsep = (float*)(P.ws + WS_LSE);
    u32x2 pa4[4], pa16[4]; float pl4 = 0.f, pl16 = 0.f;
    if (mode == 2) {
        pl4 = lsep[tokr * 6u + u.head]; pl16 = lsep[((unsigned)T + tokr) * 6u + u.head];
#pragma unroll
        for (int dt = 0; dt < 4; ++dt) {
            pa4[dt] = *(const u32x2*)(aob + tokr * 384u + u.head * 64 + dt * 16 + g * 4);
            pa16[dt] = *(const u32x2*)(aob + ((unsigned)T + tokr) * 384u + u.head * 64 + dt * 16 + g * 4);
        }
    }
    f32x4 sacc[9];
#pragma unroll
    for (int kt = 0; kt < 9; ++kt) sacc[kt] = (f32x4){0.f, 0.f, 0.f, 0.f};
    {
        s16x8 qa[2];
#pragma unroll
        for (int ks = 0; ks < 2; ++ks) qa[ks] = *(const s16x8*)(smem + AT_Q + (16 * w + r) * AT_QSTR + (32 * ks + 8 * g) * 2);
#pragma unroll
        for (int kt = 0; kt < 9; ++kt)
#pragma unroll
            for (int ks = 0; ks < 2; ++ks) {
                s16x8 kb = *(const s16x8*)(smem + AT_K + (16 * w + kt * 16 + r) * AT_QSTR + (32 * ks + 8 * g) * 2);
                sacc[kt] = __builtin_amdgcn_mfma_f32_16x16x32_bf16(kb, qa[ks], sacc[kt], 0, 0, 0);
                if (ks == 1 && (kt % 3) == 2) __builtin_amdgcn_sched_barrier(0);
            }
    }
    const float* bias = (const float*)(smem + AT_BIAS);
    constexpr float SC = 0.125f * 1.44269504088896341f;
    const float sink2 = sinkv * 1.44269504088896341f;
    const int dbase = 128 + r - g * 4;
    float mx = MASKV;
    if (qb > 0) {
#pragma unroll
        for (int kt = 0; kt < 9; ++kt)
#pragma unroll
            for (int j = 0; j < 4; ++j) {
                const int dist = dbase - 16 * kt - j;
                float v;
                if (kt >= 1 && kt <= 7) v = sacc[kt][j] * SC + bias[dist];
                else { const bool valid = (dist >= 0) && (dist <= maxd); const int dc = dist < 0 ? 0 : (dist > 128 ? 128 : dist); v = valid ? sacc[kt][j] * SC + bias[dc] : MASKV; }
                sacc[kt][j] = v;
                mx = fmaxf(mx, v);
            }
    } else {
#pragma unroll
        for (int kt = 0; kt < 9; ++kt)
#pragma unroll
            for (int j = 0; j < 4; ++j) {
                const int kl = kt * 16 + g * 4 + j;
                const int dist = 128 + r - kl;
                const int kpos = 16 * w + kl;
                const bool valid = (dist >= 0) && (dist <= maxd) && (kpos >= 128);
                const int dc = dist < 0 ? 0 : (dist > 128 ? 128 : dist);
                const float v = valid ? sacc[kt][j] * SC + bias[dc] : MASKV;
                sacc[kt][j] = v;
                mx = fmaxf(mx, v);
            }
    }
    mx = fmaxf(mx, xshfl<16>(mx)); mx = fmaxf(mx, xshfl<32>(mx));
    if (has_sink) mx = fmaxf(mx, sink2);
    float den = 0.f;
    const int pw = AT_P + w * 16 * AT_PSTR;
#pragma unroll
    for (int kt = 0; kt < 10; ++kt) {
        f32x4 p = {0.f, 0.f, 0.f, 0.f};
        if (kt < 9) {
#pragma unroll
            for (int j = 0; j < 4; ++j) { p[j] = __builtin_amdgcn_exp2f(sacc[kt < 9 ? kt : 0][j] - mx); den += p[j]; }
        }
        u32x2 pk; pk[0] = pack2(p[0], p[1]); pk[1] = pack2(p[2], p[3]);
        *(u32x2*)(smem + pw + r * AT_PSTR + (kt * 16 + g * 4) * 2) = pk;
    }
    den += xshfl<16>(den); den += xshfl<32>(den);
    if (has_sink) den += __builtin_amdgcn_exp2f(sink2 - mx);
    __builtin_amdgcn_fence(__ATOMIC_RELEASE, "workgroup");
    __builtin_amdgcn_wave_barrier();
    __builtin_amdgcn_fence(__ATOMIC_ACQUIRE, "workgroup");
    f32x4 oacc[4];
#pragma unroll
    for (int dt = 0; dt < 4; ++dt) oacc[dt] = (f32x4){0.f, 0.f, 0.f, 0.f};
#pragma unroll
    for (int ks = 0; ks < 5; ++ks) {
        s16x8 pa = *(const s16x8*)(smem + pw + r * AT_PSTR + (32 * ks + 8 * g) * 2);
#pragma unroll
        for (int dt = 0; dt < 4; ++dt) {
            const int o = AT_V + (16 * w + 32 * ks + 8 * g + (r >> 2)) * AT_VSTR + (dt * 16 + 4 * (lane & 3)) * 2;
            s16x4 lo = __builtin_amdgcn_ds_read_tr16_b64_v4i16((LAS s16x4*)(smem + o));
            s16x4 hi = __builtin_amdgcn_ds_read_tr16_b64_v4i16((LAS s16x4*)(smem + o + 4 * AT_VSTR));
            s16x8 vb = (s16x8){lo[0], lo[1], lo[2], lo[3], hi[0], hi[1], hi[2], hi[3]};
            oacc[dt] = __builtin_amdgcn_mfma_f32_16x16x32_bf16(vb, pa, oacc[dt], 0, 0, 0);
        }
    }
    const float inv = 1.0f / den;
    if (mode == 0) {
        u16* ao = aob + ((unsigned)u.pidx * (unsigned)T + tokr) * 384u + u.head * 64 + g * 4;
#pragma unroll
        for (int dt = 0; dt < 4; ++dt) { u32x2 pk; pk[0] = pack2(oacc[dt][0] * inv, oacc[dt][1] * inv); pk[1] = pack2(oacc[dt][2] * inv, oacc[dt][3] * inv); *(u32x2*)(ao + dt * 16) = pk; }
        if (g == 0) lsep[((unsigned)u.pidx * (unsigned)T + tokr) * 6u + u.head] = mx + __builtin_amdgcn_logf(den);
    } else if (mode == 1) {
        u16* ob = (u16*)(P.ws + WS_OBUF) + tokr * 1024u + 768 + u.head * 64 + g * 4;
#pragma unroll
        for (int dt = 0; dt < 4; ++dt) { u32x2 pk; pk[0] = pack2(oacc[dt][0] * inv, oacc[dt][1] * inv); pk[1] = pack2(oacc[dt][2] * inv, oacc[dt][3] * inv); *(u32x2*)(ob + dt * 16) = pk; }
    } else {
        const float l1 = mx + __builtin_amdgcn_logf(den);
        const float mm = fmaxf(l1, fmaxf(pl4, pl16));
        const float w1 = __builtin_amdgcn_exp2f(l1 - mm), w4 = __builtin_amdgcn_exp2f(pl4 - mm), w16 = __builtin_amdgcn_exp2f(pl16 - mm);
        const float wi = 1.0f / (w1 + w4 + w16);
        const float c1 = w1 * inv * wi, c4 = w4 * wi, c16 = w16 * wi;
        u16* ob = (u16*)(P.ws + WS_OBUF) + tokr * 1024u + u.head * 64 + g * 4;
#pragma unroll
        for (int dt = 0; dt < 4; ++dt) {
            const float a0 = __uint_as_float(pa4[dt][0] << 16), a1 = __uint_as_float(pa4[dt][0] & 0xffff0000u), a2 = __uint_as_float(pa4[dt][1] << 16), a3 = __uint_as_float(pa4[dt][1] & 0xffff0000u);
            const float b0 = __uint_as_float(pa16[dt][0] << 16), b1 = __uint_as_float(pa16[dt][0] & 0xffff0000u), b2 = __uint_as_float(pa16[dt][1] << 16), b3 = __uint_as_float(pa16[dt][1] & 0xffff0000u);
            u32x2 pk;
            pk[0] = pack2(c1 * oacc[dt][0] + c4 * a0 + c16 * b0, c1 * oacc[dt][1] + c4 * a1 + c16 * b1);
            pk[1] = pack2(c1 * oacc[dt][2] + c4 * a2 + c16 * b2, c1 * oacc[dt][3] + c4 * a3 + c16 * b3);
            *(u32x2*)(ob + dt * 16) = pk;
        }
    }
}

template <int which>
__device__ __forceinline__ void attn_phase(const Params& P, int l, int bid, int G) {
    const int t = tid_opaque();
    AUnit cur, nxt; ARegs R;
    int idx = bid;
    bool have = attn_decode<which>(P, l, idx, cur);
    if (have) attn_gload(P, cur, R, t);
    if (t < 256) *(u32x4*)(smem + AT_V + (256 + (t >> 3)) * AT_VSTR + (t & 7) * 16) = (u32x4){0u, 0u, 0u, 0u};
    while (have) {
        __syncthreads();
        attn_lstore(R, t);
        __syncthreads();
        idx += G;
        const bool hn = attn_decode<which>(P, l, idx, nxt);
        if (hn) attn_gload(P, nxt, R, t);
        attn_compute<which>(P, cur, t);
        cur = nxt; have = hn;
    }
    __syncthreads();
}

constexpr int HG_QS = 272, HG_QM = LDS_HDR, HG_KM = HG_QM + 64 * HG_QS, HG_KD = HG_KM + 64 * HG_QS, HG_QD = HG_KD + 64 * HG_QS,
              HG_I = HG_QD + 64 * HG_QS, HG_IS = 208, HG_P = HG_I + 64 * HG_IS, HG_PS = 144, HG_ST = HG_P + 64 * HG_PS, HG_PART = HG_ST + 96 * HG_QS,
              HG_DEC = HG_PART + 2048, HG_END = HG_DEC + 512;
static_assert(HG_END <= LDS_BYTES, "lds hgrn");

__device__ __forceinline__ void hgrn_group(const Params& P, int l, int b, int h, int g) {
    const int t = tid_opaque(), lane = t & 63, w = t >> 6;
    const int k = t & 127, tq = t >> 7;
    const u16* qkvp = (const u16*)(P.ws + WS_QKV);
    u16* qg = (u16*)(P.ws + WS_QG);
    float* ol = (float*)(P.ws + WS_BRAW);
    const int tok0 = b * SEQ + g * 512;
    float lb = 0.f;
    if (l == 1) lb = sigmoidf_(P.lbl[512 + h * 128 + k] - P.lbl[h * 128 + k]);
    const float om = 1.f - lb;
    float cumG = 0.f;
    f32x4 S[6];
#pragma unroll
    for (int i = 0; i < 6; ++i) S[i] = (f32x4){0.f, 0.f, 0.f, 0.f};
    for (int i = t; i < 96 * HG_QS / 16; i += NTHREADS) *(uint4*)(smem + HG_ST + i * 16) = make_uint4(0u, 0u, 0u, 0u);
    u16 rq[16], rf[16];
#pragma unroll
    for (int j = 0; j < 16; ++j) {
        const size_t tok = (size_t)tok0 + tq * 16 + j;
        rq[j] = qkvp[tok * INW + C_BQ + h * 128 + k]; rf[j] = qkvp[tok * INW + C_BF + h * 128 + k];
    }
    for (int c = 0; c < 8; ++c) {
        const int tokc = tok0 + c * 64;
#pragma unroll
        for (int i = 0; i < 2; ++i) {
            const int idx = t + i * NTHREADS;
            if (idx < 768) { const int row = idx / 12, cc = idx % 12;
                *(uint4*)(smem + HG_I + row * HG_IS + cc * 16) = *(const uint4*)(qkvp + (size_t)(tokc + row) * INW + C_BI + h * 96 + cc * 8); }
        }
        float qs[16], ky[16], cum[16];
        float run = 0.f;
#pragma unroll
        for (int j = 0; j < 16; ++j) {
            const float qv = bf2f(rq[j]), fv = bf2f(rf[j]);
            const float ee = __builtin_amdgcn_exp2f(fv * -1.44269504088896341f), sg = __builtin_amdgcn_rcpf(1.0f + ee);
            const float forget = lb + om * sg;
            run += __builtin_amdgcn_logf(forget) * 0.693147180559945309f;
            cum[j] = run; ky[j] = om * ee * sg; qs[j] = qv * fsigmoid(qv);
        }
        ((float*)(smem + HG_PART))[tq * 128 + k] = run;
        __syncthreads();
        if (c + 1 < 8) {
#pragma unroll
            for (int j = 0; j < 16; ++j) {
                const size_t tok = (size_t)tokc + 64 + tq * 16 + j;
                rq[j] = qkvp[tok * INW + C_BQ + h * 128 + k]; rf[j] = qkvp[tok * INW + C_BF + h * 128 + k];
            }
        }
        {
            const float* part = (const float*)(smem + HG_PART);
            const float p0 = part[k], p1 = part[128 + k], p2 = part[256 + k], p3 = part[384 + k];
            const float off = tq == 0 ? 0.f : (tq == 1 ? p0 : (tq == 2 ? p0 + p1 : p0 + p1 + p2));
            const float last = p0 + p1 + p2 + p3, cmid = p0 + p1;
            const float em = __expf(-cmid), eg = __expf(cumG);
#pragma unroll
            for (int j = 0; j < 16; ++j) {
                const float cu = off + cum[j];
                const int row = tq * 16 + j;
                const float qd = qs[j] * __expf(cu);
                *(u16*)(smem + HG_QM + row * HG_QS + k * 2) = f2bf(qd * em);
                *(u16*)(smem + HG_KM + row * HG_QS + k * 2) = f2bf(ky[j] * __expf(cmid - cu));
                *(u16*)(smem + HG_KD + row * HG_QS + k * 2) = f2bf(ky[j] * __expf(last - cu));
                *(u16*)(smem + HG_QD + row * HG_QS + k * 2) = f2bf(qd);
                qg[(size_t)(tokc + row) * 512 + h * 128 + k] = f2bf(qd * eg);
            }
            if (tq == 0) ((float*)(smem + HG_DEC))[k] = __expf(last);
            cumG += last;
        }
        __syncthreads();
#pragma unroll
        for (int i = 0; i < 2; ++i) {
            const int ti = w * 2 + i, st = ti >> 2, tt = ti & 3;
            f32x4 sc = {0.f, 0.f, 0.f, 0.f};
            if (tt >= st) {
#pragma unroll
                for (int ks = 0; ks < 4; ++ks) {
                    const s16x8 a = *(const s16x8*)(smem + HG_KM + (st * 16 + (lane & 15)) * HG_QS + (32 * ks + 8 * (lane >> 4)) * 2);
                    const s16x8 bq = *(const s16x8*)(smem + HG_QM + (tt * 16 + (lane & 15)) * HG_QS + (32 * ks + 8 * (lane >> 4)) * 2);
                    sc = __builtin_amdgcn_mfma_f32_16x16x32_bf16(a, bq, sc, 0, 0, 0);
                }
            }
            const int tg = tt * 16 + (lane & 15), sg0 = st * 16 + (lane >> 4) * 4;
            uint2 pk;
            pk.x = pack2(sg0 + 0 <= tg ? sc[0] : 0.f, sg0 + 1 <= tg ? sc[1] : 0.f);
            pk.y = pack2(sg0 + 2 <= tg ? sc[2] : 0.f, sg0 + 3 <= tg ? sc[3] : 0.f);
            *(uint2*)(smem + HG_P + tg * HG_PS + sg0 * 2) = pk;
        }
        f32x4 oacc[3];
#pragma unroll
        for (int i = 0; i < 3; ++i) {
            const int oi = w * 3 + i, tt = oi / 6, vt = oi % 6;
            oacc[i] = (f32x4){0.f, 0.f, 0.f, 0.f};
#pragma unroll
            for (int ks = 0; ks < 4; ++ks) {
                const s16x8 a = *(const s16x8*)(smem + HG_QD + (tt * 16 + (lane & 15)) * HG_QS + (32 * ks + 8 * (lane >> 4)) * 2);
                const s16x8 bs = *(const s16x8*)(smem + HG_ST + (vt * 16 + (lane & 15)) * HG_QS + (32 * ks + 8 * (lane >> 4)) * 2);
                oacc[i] = __builtin_amdgcn_mfma_f32_16x16x32_bf16(a, bs, oacc[i], 0, 0, 0);
            }
        }
        __syncthreads();
#pragma unroll
        for (int i = 0; i < 3; ++i) {
            const int oi = w * 3 + i, tt = oi / 6, vt = oi % 6;
#pragma unroll
            for (int ks = 0; ks < 2; ++ks) {
                const s16x8 a = *(const s16x8*)(smem + HG_P + (tt * 16 + (lane & 15)) * HG_PS + (32 * ks + 8 * (lane >> 4)) * 2);
                const int o = HG_I + (32 * ks + 8 * (lane >> 4) + ((lane & 15) >> 2)) * HG_IS + (vt * 16 + 4 * (lane & 3)) * 2;
                const s16x4 lo = __builtin_amdgcn_ds_read_tr16_b64_v4i16((LAS s16x4*)(smem + o));
                const s16x4 hi = __builtin_amdgcn_ds_read_tr16_b64_v4i16((LAS s16x4*)(smem + o + 4 * HG_IS));
                const s16x8 bi = (s16x8){lo[0], lo[1], lo[2], lo[3], hi[0], hi[1], hi[2], hi[3]};
                oacc[i] = __builtin_amdgcn_mfma_f32_16x16x32_bf16(a, bi, oacc[i], 0, 0, 0);
            }
#pragma unroll
            for (int r = 0; r < 4; ++r)
                ol[(size_t)(tokc + tt * 16 + (lane >> 4) * 4 + r) * 384 + h * 96 + vt * 16 + (lane & 15)] = oacc[i][r];
        }
        {
            const f32x4 dec = *(const f32x4*)(smem + HG_DEC + (w * 16 + (lane >> 4) * 4) * 4);
            s16x8 ak[2];
#pragma unroll
            for (int ks = 0; ks < 2; ++ks) {
                const int o = HG_KD + (32 * ks + 8 * (lane >> 4) + ((lane & 15) >> 2)) * HG_QS + (w * 16 + 4 * (lane & 3)) * 2;
                const s16x4 lo = __builtin_amdgcn_ds_read_tr16_b64_v4i16((LAS s16x4*)(smem + o));
                const s16x4 hi = __builtin_amdgcn_ds_read_tr16_b64_v4i16((LAS s16x4*)(smem + o + 4 * HG_QS));
                ak[ks] = (s16x8){lo[0], lo[1], lo[2], lo[3], hi[0], hi[1], hi[2], hi[3]};
            }
#pragma unroll
            for (int i = 0; i < 6; ++i) {
                S[i] = S[i] * dec;
#pragma unroll
                for (int ks = 0; ks < 2; ++ks) {
                    const int o = HG_I + (32 * ks + 8 * (lane >> 4) + ((lane & 15) >> 2)) * HG_IS + (i * 16 + 4 * (lane & 3)) * 2;
                    const s16x4 lo = __builtin_amdgcn_ds_read_tr16_b64_v4i16((LAS s16x4*)(smem + o));
                    const s16x4 hi = __builtin_amdgcn_ds_read_tr16_b64_v4i16((LAS s16x4*)(smem + o + 4 * HG_IS));
                    const s16x8 bi = (s16x8){lo[0], lo[1], lo[2], lo[3], hi[0], hi[1], hi[2], hi[3]};
                    S[i] = __builtin_amdgcn_mfma_f32_16x16x32_bf16(ak[ks], bi, S[i], 0, 0, 0);
                }
                uint2 pk; pk.x = pack2(S[i][0], S[i][1]); pk.y = pack2(S[i][2], S[i][3]);
                *(uint2*)(smem + HG_ST + (i * 16 + (lane & 15)) * HG_QS + (w * 16 + (lane >> 4) * 4) * 2) = pk;
            }
        }
        __syncthreads();
    }
    {
        const int gi = (b * 4 + h) * 16 + g;
        float* sgp = (float*)(P.ws + WS_SG) + (size_t)gi * 12288;
#pragma unroll
        for (int i = 0; i < 6; ++i)
#pragma unroll
            for (int r = 0; r < 4; ++r) sgp[(w * 16 + (lane >> 4) * 4 + r) * 96 + i * 16 + (lane & 15)] = S[i][r];
        if (tq == 0) ((float*)(P.ws + WS_DG))[gi * 128 + k] = __expf(cumG);
    }
}

__device__ __forceinline__ void hgrn_fix(const Params& P, int l, int b, int h, int g) {
    const int t = tid_opaque(), lane = t & 63, w = t >> 6;
    const u16* qkvp = (const u16*)(P.ws + WS_QKV);
    const u16* qg = (const u16*)(P.ws + WS_QG);
    const float* ol = (const float*)(P.ws + WS_BRAW);
    u16* ob = (u16*)(P.ws + WS_OBUF);
    const int tok0 = b * SEQ + g * 512;
    const int gi0 = (b * 4 + h) * 16;
    float* wgt = (float*)(smem + HG_PART);
    wgt = (float*)(smem + HG_QM);
    if (t == 0) *(volatile int*)(smem + HG_DEC) = 16;
    __syncthreads();
    if (t < 128) {
        float d[16];
#pragma unroll
        for (int j = 0; j < 16; ++j) d[j] = (j < g) ? ((const float*)(P.ws + WS_DG))[(gi0 + j) * 128 + t] : 1.0f;
        float run = 1.0f; int jmin = 16;
#pragma unroll
        for (int j = 15; j >= 0; --j) { wgt[j * 128 + t] = run; if (j < g && run != 0.0f) jmin = j; run *= d[j]; }
        atomicMin((int*)(smem + HG_DEC), jmin);
    }
    __syncthreads();
    const int jfirst = *(volatile int*)(smem + HG_DEC);
    {
        float S[24];
#pragma unroll
        for (int j = 0; j < 24; ++j) S[j] = 0.f;
        const float* sg0 = (const float*)(P.ws + WS_SG) + (size_t)gi0 * 12288;
#pragma unroll 2
        for (int gj = jfirst; gj < g; ++gj) {
#pragma unroll
            for (int j = 0; j < 24; ++j) { const unsigned e = (unsigned)(j * NTHREADS) + (unsigned)t; S[j] += wgt[gj * 128 + e / 96u] * sg0[(unsigned)gj * 12288u + e]; }
        }
#pragma unroll
        for (int j = 0; j < 24; ++j) { const int e = j * NTHREADS + t, kk = e / 96, v = e % 96; *(u16*)(smem + HG_ST + v * HG_QS + kk * 2) = f2bf(S[j]); }
    }
    __syncthreads();
    const float* hg = P.hg + l * 384 + h * 96;
#pragma unroll 1
    for (int i = 0; i < 4; ++i) {
        const int tokt = tok0 + (w * 4 + i) * 16;
        const int tok = tokt + (lane & 15);
        s16x8 bq[4]; f32x4 o4[6]; u32x2 gr[6];
#pragma unroll
        for (int ks = 0; ks < 4; ++ks) bq[ks] = *(const s16x8*)(qg + (size_t)tok * 512 + h * 128 + 32 * ks + 8 * (lane >> 4));
#pragma unroll
        for (int vt = 0; vt < 6; ++vt) {
            const int vc = vt * 16 + (lane >> 4) * 4;
            o4[vt] = *(const f32x4*)(ol + (size_t)tok * 384 + h * 96 + vc);
            gr[vt] = *(const u32x2*)(qkvp + (size_t)tok * INW + C_BG + h * 96 + vc);
        }
        f32x4 acc[6];
#pragma unroll
        for (int vt = 0; vt < 6; ++vt) acc[vt] = (f32x4){0.f, 0.f, 0.f, 0.f};
#pragma unroll
        for (int ks = 0; ks < 4; ++ks) {
#pragma unroll
            for (int vt = 0; vt < 6; ++vt) {
                const s16x8 a = *(const s16x8*)(smem + HG_ST + (vt * 16 + (lane & 15)) * HG_QS + (32 * ks + 8 * (lane >> 4)) * 2);
                acc[vt] = __builtin_amdgcn_mfma_f32_16x16x32_bf16(a, bq[ks], acc[vt], 0, 0, 0);
            }
            __builtin_amdgcn_sched_barrier(0);
        }
        float ss = 0.f;
#pragma unroll
        for (int vt = 0; vt < 6; ++vt) {
            acc[vt] = acc[vt] + o4[vt];
            ss += acc[vt][0] * acc[vt][0] + acc[vt][1] * acc[vt][1] + acc[vt][2] * acc[vt][2] + acc[vt][3] * acc[vt][3];
        }
        ss += xshfl<16>(ss); ss += xshfl<32>(ss);
        const float rs = rsqrtf(ss * (1.0f / 96.0f) + 1e-6f);
#pragma unroll
        for (int vt = 0; vt < 6; ++vt) {
            const int vc = vt * 16 + (lane >> 4) * 4;
            const f32x4 hv = *(const f32x4*)(hg + vc);
            const float g0 = __uint_as_float(gr[vt][0] << 16), g1 = __uint_as_float(gr[vt][0] & 0xffff0000u), g2 = __uint_as_float(gr[vt][1] << 16), g3 = __uint_as_float(gr[vt][1] & 0xffff0000u);
            u32x2 pk;
            pk[0] = pack2(acc[vt][0] * rs * hv[0] * (g0 * fsigmoid(g0)), acc[vt][1] * rs * hv[1] * (g1 * fsigmoid(g1)));
            pk[1] = pack2(acc[vt][2] * rs * hv[2] * (g2 * fsigmoid(g2)), acc[vt][3] * rs * hv[3] * (g3 * fsigmoid(g3)));
            *(u32x2*)(ob + (size_t)tok * 1024 + 384 + h * 96 + vc) = pk;
        }
    }
    __syncthreads();
}

constexpr int RT_ASTR = 144, RT_BSTR = 576, RT_A = 128 * RT_ASTR, RT_B = 64 * RT_BSTR, RT_STAGE = RT_A + RT_B, RT_LGS = 260;
constexpr int RT_ASG = LDS_HDR + 128 * RT_LGS * 4;
static_assert(LDS_HDR + 2 * RT_STAGE <= LDS_BYTES && RT_ASG + 12288 + 2048 <= LDS_BYTES, "lds router");
__device__ __forceinline__ void router_tile(const u16* A, const float* W) {
    const int t = tid_opaque(), lane = t & 63, w = t >> 6, wr = w >> 2, wc = w & 3;
    const int nq = t & 63, kb = t >> 6;
    u32x4 ra[2]; f32x4 rb[8];
    auto gload = [&](int kt) __attribute__((always_inline)) {
#pragma unroll
        for (int i = 0; i < 2; ++i) ra[i] = *(const u32x4*)(A + (unsigned)((t >> 3) + 64 * i) * 1024u + (t & 7) * 8 + kt * 64);
#pragma unroll
        for (int i = 0; i < 8; ++i) rb[i] = *(const f32x4*)(W + (unsigned)(kt * 64 + kb + 8 * i) * 256u + nq * 4);
    };
    auto lwrite = [&](int buf) __attribute__((always_inline)) {
        const int ab = LDS_HDR + buf * RT_STAGE, bb = ab + RT_A;
#pragma unroll
        for (int i = 0; i < 2; ++i) *(u32x4*)(smem + ab + ((t >> 3) + 64 * i) * RT_ASTR + (t & 7) * 16) = ra[i];
#pragma unroll
        for (int i = 0; i < 8; ++i) { u32x2 p; p[0] = pack2(rb[i][0], rb[i][1]); p[1] = pack2(rb[i][2], rb[i][3]); *(u32x2*)(smem + bb + (kb + 8 * i) * RT_BSTR + nq * 8) = p; }
    };
    f32x16 acc[2][2];
#pragma unroll
    for (int m = 0; m < 2; ++m)
#pragma unroll
        for (int n = 0; n < 2; ++n)
#pragma unroll
            for (int r = 0; r < 16; ++r) acc[m][n][r] = 0.f;
    const int a_rd = (wr * 64 + (lane & 31)) * RT_ASTR + (lane >> 5) * 16;
    const int b_rd = ((lane >> 5) * 8 + ((lane & 15) >> 2)) * RT_BSTR + (wc * 64 + 16 * ((lane >> 4) & 1) + 4 * (lane & 3)) * 2;
    gload(0);
    lwrite(0);
    __syncthreads();
    for (int s = 0; s < 16; ++s) {
        const int buf = s & 1;
        if (s + 1 < 16) gload(s + 1);
        const int ab = LDS_HDR + buf * RT_STAGE, bb = ab + RT_A;
#pragma unroll
        for (int kk = 0; kk < 4; ++kk) {
            s16x8 af[2], bf[2];
#pragma unroll
            for (int m = 0; m < 2; ++m) af[m] = *(const s16x8*)(smem + ab + a_rd + m * 32 * RT_ASTR + kk * 32);
#pragma unroll
            for (int n = 0; n < 2; ++n) {
                const int o = bb + b_rd + kk * 16 * RT_BSTR + n * 64;
                const s16x4 lo = __builtin_amdgcn_ds_read_tr16_b64_v4i16((LAS s16x4*)(smem + o));
                const s16x4 hi = __builtin_amdgcn_ds_read_tr16_b64_v4i16((LAS s16x4*)(smem + o + 4 * RT_BSTR));
                bf[n] = (s16x8){lo[0], lo[1], lo[2], lo[3], hi[0], hi[1], hi[2], hi[3]};
            }
#pragma unroll
            for (int m = 0; m < 2; ++m)
#pragma unroll
                for (int n = 0; n < 2; ++n) acc[m][n] = __builtin_amdgcn_mfma_f32_32x32x16_bf16(af[m], bf[n], acc[m][n], 0, 0, 0);
        }
        if (s + 1 < 16) lwrite(buf ^ 1);
        __syncthreads();
    }
    float* lg = (float*)(smem + LDS_HDR);
#pragma unroll
    for (int m = 0; m < 2; ++m)
#pragma unroll
        for (int n = 0; n < 2; ++n)
#pragma unroll
            for (int r = 0; r < 16; ++r)
                lg[(wr * 64 + m * 32 + (r & 3) + 8 * (r >> 2) + 4 * (lane >> 5)) * RT_LGS + wc * 64 + n * 32 + (lane & 31)] = acc[m][n][r];
    __syncthreads();
}

struct F8 { f32x4 lo, hi; };
__device__ __forceinline__ F8 bf8_to_f(const u32x4 r) {
    F8 o;
    o.lo = (f32x4){__uint_as_float(r[0] << 16), __uint_as_float(r[0] & 0xffff0000u), __uint_as_float(r[1] << 16), __uint_as_float(r[1] & 0xffff0000u)};
    o.hi = (f32x4){__uint_as_float(r[2] << 16), __uint_as_float(r[2] & 0xffff0000u), __uint_as_float(r[3] << 16), __uint_as_float(r[3] & 0xffff0000u)};
    return o;
}
template <int NT, class AF, class BF, class OF>
__device__ __forceinline__ void ln_tokens(AF arow, BF bfun, const float* g, const float* be, OF orow, int lane) {
    F8 v[NT][2]; float s[NT];
#pragma unroll
    for (int q = 0; q < NT; ++q) {
        const u16* a = arow(q);
        s[q] = 0.f;
#pragma unroll
        for (int j = 0; j < 2; ++j) {
            const int c = j * 512 + lane * 8;
            const F8 av = bf8_to_f(*(const u32x4*)(a + c));
            const F8 bv = bfun(q, c);
            v[q][j].lo = av.lo * ALPHA + bv.lo; v[q][j].hi = av.hi * ALPHA + bv.hi;
            s[q] += (v[q][j].lo[0] + v[q][j].lo[1]) + (v[q][j].lo[2] + v[q][j].lo[3]) + (v[q][j].hi[0] + v[q][j].hi[1]) + (v[q][j].hi[2] + v[q][j].hi[3]);
        }
    }
#define LN_RED(X) _Pragma("unroll") for (int q = 0; q < NT; ++q) X[q] += xshfl<1>(X[q]); _Pragma("unroll") for (int q = 0; q < NT; ++q) X[q] += xshfl<2>(X[q]); \
    _Pragma("unroll") for (int q = 0; q < NT; ++q) X[q] += dpp_f<0x141>(X[q]); _Pragma("unroll") for (int q = 0; q < NT; ++q) X[q] += dpp_f<0x140>(X[q]); \
    _Pragma("unroll") for (int q = 0; q < NT; ++q) X[q] += xshfl<16>(X[q]); _Pragma("unroll") for (int q = 0; q < NT; ++q) X[q] += xshfl<32>(X[q]);
    LN_RED(s)
    float qq[NT];
#pragma unroll
    for (int q = 0; q < NT; ++q) {
        const float mu = s[q] * (1.0f / 1024.0f);
        qq[q] = 0.f;
#pragma unroll
        for (int j = 0; j < 2; ++j) {
            v[q][j].lo = v[q][j].lo - mu; v[q][j].hi = v[q][j].hi - mu;
            const f32x4 a2 = v[q][j].lo * v[q][j].lo + v[q][j].hi * v[q][j].hi;
            qq[q] += (a2[0] + a2[1]) + (a2[2] + a2[3]);
        }
    }
    LN_RED(qq)
#undef LN_RED
#pragma unroll
    for (int j = 0; j < 2; ++j) {
        const int c = j * 512 + lane * 8;
        const f32x4 g0 = *(const f32x4*)(g + c), g1 = *(const f32x4*)(g + c + 4), b0 = *(const f32x4*)(be + c), b1 = *(const f32x4*)(be + c + 4);
#pragma unroll
        for (int q = 0; q < NT; ++q) {
            const float rs = rsqrtf(qq[q] * (1.0f / 1024.0f) + LN_EPS);
            orow(q, c, v[q][j].lo * rs * g0 + b0, v[q][j].hi * rs * g1 + b1);
        }
    }
}

__device__ __forceinline__ Params load_params() {
#if defined(__HIP_DEVICE_COMPILE__)
    typedef __attribute__((address_space(4))) const Params CP;
    CP* p = (CP*)__builtin_amdgcn_kernarg_segment_ptr();
    asm volatile("" : "+s"(p));
    return *p;
#else
    return Params{};
#endif
}
__device__ __forceinline__ int opq_s(int v) { asm volatile("" : "+s"(v)); return v; }
#define LOADP const Params P = load_params(); const int bid = opq_s((int)blockIdx.x), G = opq_s((int)gridDim.x); (void)bid; (void)G
#define GRID_SYNC() do { XcdBarrier b_; b_.bar = (unsigned*)(load_params().ws + WS_CTL); b_.x = xb_xcc_id(); b_.st = (volatile LAS unsigned*)smem; xcd_barrier(b_); } while (0)
__global__ void __launch_bounds__(NTHREADS, 2) fwd_kernel(Params Pk_) {
    if (threadIdx.x < 4) ((volatile unsigned*)smem)[threadIdx.x] = 0u;
    __syncthreads();
    { LOADP; (void)xcd_barrier_post((unsigned*)(P.ws + WS_CTL), (volatile LAS unsigned*)smem); }

#define qkv ((u16*)(P.ws + WS_QKV))
#define obuf ((u16*)(P.ws + WS_OBUF))
#define mix ((float*)(P.ws + WS_MIX))
#define h1 ((float*)(P.ws + WS_H1))
#define hcur ((float*)(P.ws + WS_HCUR))
#define logits ((float*)(P.ws + WS_LOGITS))
#define gatebuf ((float*)(P.ws + WS_GATE))
#define list ((int*)(P.ws + WS_LIST))
#define hbuf ((u16*)(P.ws + WS_HBUF))
#define slots ((u16*)(P.ws + WS_SLOTS))
#define hb ((u16*)(P.ws + WS_HB))
#define h1b ((u16*)(P.ws + WS_H1B))
#define h1l ((u16*)(P.ws + WS_H1L))
#define hin ((l == 0) ? P.x : (const float*)hcur)
#define count ((int*)(P.ws + WS_CTL + CTL_COUNT_OFF) + l * 256)
    int* prefix = (int*)(smem + LDS_PREFIX);

    { LOADP; const int t = tid_opaque();
    for (size_t i = ((size_t)bid * NTHREADS + t) * 4; i < (size_t)T * D; i += (size_t)G * NTHREADS * 4) {
        const f32x4 v = *(const f32x4*)(P.x + i);
        uint2 p; p.x = pack2(v[0], v[1]); p.y = pack2(v[2], v[3]);
        *(uint2*)(hb + i) = p;
    } }
    {
        LOADP;
        constexpr int NBIN = 16 * 27, NBOUT = 16 * 8;
        for (int u = bid; u < 2 * (NBIN + NBOUT); u += G) {
            const int ll = u / (NBIN + NBOUT), v = u % (NBIN + NBOUT);
            if (v < NBIN) conv_block(P.w_in + (size_t)ll * D * INW, INW, (v / 27) * 64, (v % 27) * 128, (u16*)(P.ws + WS_WIN) + (size_t)ll * 3584 * 1024, [](int n) { return (size_t)n * 1024; });
            else { const int v2 = v - NBIN; conv_block(P.w_out + (size_t)ll * 1024 * 1024, 1024, (v2 / 8) * 64, (v2 % 8) * 128, (u16*)(P.ws + WS_WOUT) + (size_t)ll * 1024 * 1024, [](int n) { return (size_t)n * 1024; }); }
        }
    }

    auto layer_body = [&](const int l) __attribute__((always_inline)) {
        if (l == 0) GRID_SYNC();
        PH(0)
        {
            LOADP;
#ifndef CONV_SIDE_WGS
#define CONV_SIDE_WGS 1
#endif
            const bool split = CONV_SIDE_WGS && (G == 256);
            const int jx = bid >> 3, qx = bid & 7;
#ifndef NCJ
#define NCJ 13
#endif
            const bool is_conv = split && (jx >= 32 - NCJ);
            const int conv_rank = split ? ((jx - (32 - NCJ)) * 8 + qx) : bid, conv_n = split ? NCJ * 8 : G;
            const int cmp_rank = bid, cmp_n = split ? (32 - NCJ) * 8 : G;
            unsigned* cvctr = (unsigned*)(P.ws + WS_CTL + CTL_COUNT_OFF + 8192) + l * 64;
            auto cvdesc = [&](int u) {
                const int e = u / 48, v = u % 48;
                CvDesc d;
                if (v < 32) {
                    const int isu = v >> 4, kbk = v & 15;
                    const float* srcw = (e < 256) ? ((isu ? P.wu : P.wg) + ((size_t)l * NE + e) * D * FF) : ((isu ? P.su : P.sg) + (size_t)l * D * FF);
                    d.src = srcw + (size_t)kbk * 64 * FF; d.ld = FF; d.dst = (u16*)((unsigned char*)(P.ws + WS_WGU) + (size_t)e * 2 * 256 * 1024 + kbk * 64); d.rs_hi = 256; d.radd = isu * 128; d.dk = 1024; d.f8 = true;
                } else {
                    const int v2 = v - 32, kbk = v2 & 3, nb = v2 >> 2;
                    const float* srcw = (e < 256) ? (P.wd + ((size_t)l * NE + e) * FF * D) : (P.sd + (size_t)l * FF * D);
                    d.src = srcw + (size_t)kbk * 64 * D + nb * 256; d.ld = D; d.dst = (u16*)((unsigned char*)(P.ws + WS_WD) + (size_t)e * 1024 * 256 + (size_t)nb * 256 * 256 + kbk * 64); d.rs_hi = 128; d.radd = 0; d.dk = 256; d.f8 = true;
                }
                return d;
            };
            if (is_conv) conv_stream_dyn(257 * 48, cvctr, cvdesc);
            if (!is_conv) {
            eg::DenseSched S; S.A = (const char*)hb; S.Bt = (const char*)(P.ws + WS_WIN) + (size_t)l * 3584 * 1024 * 2; S.K = 1024; S.nM = 128; S.nN = 14; S.nwg = 128 * 14; S.G = cmp_n; S.c = cmp_rank;
            u16* q = qkv;
            eg::gemm_stream<1, false, 0>(2048, 2048, S, [&](const f32x4 (&acc)[2][2][4][2], const eg::DenseUnit& u, int wr, int wc, int fr, int fq, const LAS unsigned*) {
#pragma unroll
                for (int ai = 0; ai < 2; ++ai)
#pragma unroll
                    for (int m = 0; m < 4; ++m) {
                        u16* rowp = q + (size_t)(u.pm * 256 + ai * 128 + wr * 64 + m * 16 + fr) * INW + u.pn * 256 + wc * 32 + 8 * fq;
#pragma unroll
                        for (int bj = 0; bj < 2; ++bj) {
                            if (u.pn * 256 + bj * 128 < INW) {
                                const f32x4 v0 = acc[ai][bj][m][0], v1 = acc[ai][bj][m][1];
                                u32x4 p; p[0] = pack2(v0[0], v0[1]); p[1] = pack2(v0[2], v0[3]); p[2] = pack2(v1[0], v1[1]); p[3] = pack2(v1[2], v1[3]);
                                *(u32x4*)(rowp + bj * 128) = p;
                            }
                        }
                    }
            });
            conv_stream_dyn(257 * 48, cvctr, cvdesc);
            }
        }
        GRID_SYNC();
        PH(1)
        {
            LOADP;
            for (int r2 = 0; r2 < (((REPMASK >> 11) & 1) ? 2 : 1); ++r2) for (int u = bid; u < 256; u += G) hgrn_group(P, l, u >> 6, (u >> 4) & 3, u & 15);
            for (int r2 = 0; r2 < (((REPMASK >> 12) & 1) ? 2 : 1); ++r2) attn_phase<0>(P, l, bid, G);
        }
        GRID_SYNC();
        PH(2)
        {
            LOADP;
            for (int r2 = 0; r2 < (((REPMASK >> 13) & 1) ? 2 : 1); ++r2) for (int u = bid; u < 256; u += G) hgrn_fix(P, l, u >> 6, (u >> 4) & 3, u & 15);
            for (int r2 = 0; r2 < (((REPMASK >> 14) & 1) ? 2 : 1); ++r2) attn_phase<1>(P, l, bid, G);
        }
        GRID_SYNC();
        PH(3)
        {
            LOADP;
            eg::DenseSched S; S.A = (const char*)obuf; S.Bt = (const char*)(P.ws + WS_WOUT) + (size_t)l * 1024 * 1024 * 2; S.K = 1024; S.nM = 128; S.nN = 4; S.nwg = 128 * 4; S.G = G; S.c = bid;
            u16* mx = (u16*)(P.ws + WS_MIX);
            eg::gemm_stream<1, false, 0>(2048, 2048, S, [&](const f32x4 (&acc)[2][2][4][2], const eg::DenseUnit& u, int wr, int wc, int fr, int fq, const LAS unsigned*) {
#pragma unroll
                for (int ai = 0; ai < 2; ++ai)
#pragma unroll
                    for (int m = 0; m < 4; ++m) {
                        u16* rowp = mx + (size_t)(u.pm * 256 + ai * 128 + wr * 64 + m * 16 + fr) * 1024 + u.pn * 256 + wc * 32 + 8 * fq;
#pragma unroll
                        for (int bj = 0; bj < 2; ++bj) {
                            const f32x4 v0 = acc[ai][bj][m][0], v1 = acc[ai][bj][m][1];
                            u32x4 p; p[0] = pack2(v0[0], v0[1]); p[1] = pack2(v0[2], v0[3]); p[2] = pack2(v1[0], v1[1]); p[3] = pack2(v1[2], v1[3]);
                            *(u32x4*)(rowp + bj * 128) = p;
                        }
                    }
            });
        }
        GRID_SYNC();
        PH(4)
        {
            LOADP;
            const int t = tid_opaque(), lane = t & 63, wave = t >> 6;
            const float* rb = P.rb + l * 256;
            const f32x4 bias4 = *(const f32x4*)(rb + lane * 4);
            int* asg_e = (int*)(smem + RT_ASG); int* asg_r = asg_e + 1024; float* asg_g = (float*)(asg_r + 1024);
            int* lhist = (int*)(asg_g + 1024); int* gbase = lhist + 256;
            for (int blk = bid; blk < T / 128; blk += G) {
            for (int r2 = 0; r2 < (((REPMASK >> 15) & 1) ? 2 : 1); ++r2)
            for (int i = 0; i < 16; i += 4) {
                const int tokb = blk * 128 + wave * 16 + i;
                const u16* mixp = (const u16*)(P.ws + WS_MIX);
                ln_tokens<4>([&](int q) { return (const u16*)hb + (size_t)(tokb + q) * 1024; },
                             [&](int q, int c) { return bf8_to_f(*(const u32x4*)(mixp + (size_t)(tokb + q) * 1024 + c)); },
                             P.ln1g + l * 1024, P.ln1b + l * 1024,
                             [&](int q, int c, const f32x4 y0, const f32x4 y1) {
                                 u32x4 p; p[0] = pack2(y0[0], y0[1]); p[1] = pack2(y0[2], y0[3]); p[2] = pack2(y1[0], y1[1]); p[3] = pack2(y1[2], y1[3]);
                                 *(u32x4*)(h1b + (size_t)(tokb + q) * 1024 + c) = p;
                                 u32x2 p8;
                                 p8[0] = (unsigned)__builtin_amdgcn_cvt_pk_fp8_f32(y0[2], y0[3], __builtin_amdgcn_cvt_pk_fp8_f32(y0[0], y0[1], 0, false), true);
                                 p8[1] = (unsigned)__builtin_amdgcn_cvt_pk_fp8_f32(y1[2], y1[3], __builtin_amdgcn_cvt_pk_fp8_f32(y1[0], y1[1], 0, false), true);
                                 *(u32x2*)((unsigned char*)(P.ws + WS_H1L) + (size_t)(tokb + q) * 1024 + c) = p8; }, lane);
            }
            asm volatile("s_waitcnt vmcnt(0)" ::: "memory");
            __syncthreads();
            __builtin_amdgcn_fence(__ATOMIC_ACQUIRE, "agent");
            for (int r2 = 0; r2 < (((REPMASK >> 16) & 1) ? 2 : 1); ++r2) router_tile(h1b + (size_t)blk * 128 * 1024, P.rw + (size_t)l * 1024 * 256);
            if (t < 256) lhist[t] = 0;
            __syncthreads();
            for (int r3 = 0; r3 < (((REPMASK >> 17) & 1) ? 2 : 1); ++r3)
            for (int it0 = 0; it0 < 16; it0 += 4) {
                int tokq[4]; bool okq[4];
                float s[4][4], c[4][4];
#pragma unroll
                for (int q = 0; q < 4; ++q) {
                    tokq[q] = blk * 128 + wave * 16 + it0 + q; okq[q] = true;
                    const f32x4 lg = *(const f32x4*)((const float*)(smem + LDS_HDR) + (wave * 16 + it0 + q) * RT_LGS + lane * 4);
#pragma unroll
                    for (int j = 0; j < 4; ++j) { s[q][j] = fsigmoid(lg[j]); c[q][j] = s[q][j] + bias4[j]; }
                }
                float a1[4], a2[4];
#pragma unroll
                for (int q = 0; q < 4; ++q) {
                    a1[q] = rmax(c[q][0], c[q][1]); a2[q] = rmin(c[q][0], c[q][1]);
                    const float b1 = rmax(c[q][2], c[q][3]), b2 = rmin(c[q][2], c[q][3]); const float n1 = rmax(a1[q], b1); a2[q] = rmax(rmin(a1[q], b1), rmax(a2[q], b2)); a1[q] = n1;
                }
#define RT_G(C) _Pragma("unroll") for (int q = 0; q < 4; ++q) { const float b1 = dpp_f<C>(a1[q]), b2 = dpp_f<C>(a2[q]); const float n1 = rmax(a1[q], b1); a2[q] = rmax(rmin(a1[q], b1), rmax(a2[q], b2)); a1[q] = n1; }
                RT_G(0xB1) RT_G(0x4E) RT_G(0x141)
#undef RT_G
                const int myg = lane >> 3;
#pragma unroll
                for (int q = 0; q < 4; ++q) {
                    const float gs = a1[q] + a2[q];
                    int rank = 0;
#pragma unroll
                    for (int g2 = 0; g2 < 8; ++g2) {
                        const float og = __int_as_float(__builtin_amdgcn_readlane(__float_as_int(gs), g2 * 8));
                        rank += (og > gs || (og == gs && g2 < myg)) ? 1 : 0;
                    }
                    const bool gok = rank < 4;
#pragma unroll
                    for (int j = 0; j < 4; ++j) c[q][j] = gok ? c[q][j] : MASKV;
                }
                int sel_e[4]; float sel_s[4], ssum[4];
#pragma unroll
                for (int q = 0; q < 4; ++q) { sel_e[q] = 0; sel_s[q] = 0.f; ssum[q] = 0.f; }
#pragma unroll
                for (int k = 0; k < 8; ++k) {
                    float wm[4];
#pragma unroll
                    for (int q = 0; q < 4; ++q) wm[q] = rmax(rmax(c[q][0], c[q][1]), rmax(c[q][2], c[q][3]));
#define RT_M(C) _Pragma("unroll") for (int q = 0; q < 4; ++q) wm[q] = rmax(wm[q], dpp_f<C>(wm[q]));
                    RT_M(0xB1) RT_M(0x4E) RT_M(0x141) RT_M(0x140)
#undef RT_M
#pragma unroll
                    for (int q = 0; q < 4; ++q) {
                        const float r0 = __int_as_float(__builtin_amdgcn_readlane(__float_as_int(wm[q]), 15)), r1 = __int_as_float(__builtin_amdgcn_readlane(__float_as_int(wm[q]), 31));
                        const float r2 = __int_as_float(__builtin_amdgcn_readlane(__float_as_int(wm[q]), 47)), r3v = __int_as_float(__builtin_amdgcn_readlane(__float_as_int(wm[q]), 63));
                        const float wmax = fmaxf(fmaxf(r0, r1), fmaxf(r2, r3v));
                        int best = 1 << 20;
#pragma unroll
                        for (int j = 0; j < 4; ++j) {
                            const unsigned long long mk = __builtin_amdgcn_ballot_w64(c[q][j] == wmax);
                            const int idx = mk ? (__builtin_ctzll(mk) * 4 + j) : (1 << 20);
                            best = idx < best ? idx : best;
                        }
                        const int own = best >> 2, jj = best & 3;
                        const float smine = jj == 0 ? s[q][0] : (jj == 1 ? s[q][1] : (jj == 2 ? s[q][2] : s[q][3]));
                        const float sv = __int_as_float(__builtin_amdgcn_readlane(__float_as_int(smine), own));
                        if (lane == own) {
#pragma unroll
                            for (int j = 0; j < 4; ++j) if (jj == j) c[q][j] = -3.0e38f;
                        }
                        ssum[q] += sv;
                        if (lane == k) { sel_e[q] = best; sel_s[q] = sv; }
                    }
                }
#pragma unroll
                for (int q = 0; q < 4; ++q) {
                    if (okq[q] && r3 == (((REPMASK >> 17) & 1) ? 1 : 0)) {
                        if (lane < 8) {
                            const int a = (wave * 16 + it0 + q) * 8 + lane;
                            asg_e[a] = sel_e[q]; asg_r[a] = atomicAdd(&lhist[sel_e[q]], 1); asg_g[a] = sel_s[q] / ssum[q] * 2.5f;
                        } else if (lane == 8) {
                            ((unsigned*)(P.ws + WS_RDST))[(size_t)256 * T + tokq[q]] = ((unsigned)tokq[q] * 9u + 8u) * 1024u;
                            ((float*)(P.ws + WS_RGATE))[(size_t)256 * T + tokq[q]] = 1.0f;
                        }
                    }
                }
            }
            __syncthreads();
            if (t < 256) { const int c = lhist[t]; gbase[t] = c ? atomicAdd(&count[t], c) : 0; }
            __syncthreads();
            for (int a = t; a < 1024; a += NTHREADS) {
                const int k = a & 7, tok = blk * 128 + (a >> 3);
                if (tok < T) {
                    const int e = asg_e[a]; const int pos = gbase[e] + asg_r[a];
                    list[(size_t)e * T + pos] = tok * 8 + k;
                    ((unsigned*)(P.ws + WS_RDST))[(size_t)e * T + pos] = ((unsigned)tok * 9u + (unsigned)k) * 1024u;
                    ((float*)(P.ws + WS_RGATE))[(size_t)e * T + pos] = asg_g[a];
                }
            }
            __syncthreads();
            }
        }
        GRID_SYNC();
        {
            LOADP;
            const int t = tid_opaque();
            int* tmp = (int*)(smem + LDS_HDR);
            if (t < NE) tmp[t] = (count[t] + 255) >> 8;
            __syncthreads();
            if (t < 64) {
                const int a0 = tmp[t * 4], a1 = tmp[t * 4 + 1], a2 = tmp[t * 4 + 2], a3 = tmp[t * 4 + 3];
                const int s = a0 + a1 + a2 + a3;
                int inc = s;
#pragma unroll
                for (int o = 1; o < 64; o <<= 1) { const int v = __builtin_amdgcn_ds_bpermute(((t & 63) - o) << 2, inc); if ((t & 63) >= o) inc += v; }
                const int ex = inc - s;
                prefix[t * 4] = ex; prefix[t * 4 + 1] = ex + a0; prefix[t * 4 + 2] = ex + a0 + a1; prefix[t * 4 + 3] = ex + a0 + a1 + a2;
                if (t == 63) prefix[NE] = inc;
            }
            __syncthreads();
        }
        const int ntiles = prefix[NE];
        {
            LOADP;
            const int t = tid_opaque();
            for (int tile = t; tile < ntiles; tile += NTHREADS) {
                int jj = 0;
#pragma unroll 1
                for (int s = 128; s > 0; s >>= 1) if (prefix[jj + s] <= tile) jj += s;
                const int mt = tile - prefix[jj]; int cn = count[jj] - mt * 256; cn = cn > 256 ? 256 : cn;
                ((unsigned*)(smem + eg::EG_TAB))[tile] = (unsigned)jj | ((unsigned)mt << 9) | ((unsigned)cn << 16);
            }
            for (int e = bid; e < NE; e += G) {
                const int ce = count[e];
                for (int r = ce + t; r < ((ce + 255) & ~255); r += NTHREADS) {
                    ((unsigned*)(P.ws + WS_RDST))[(size_t)e * T + r] = (unsigned)T * 9u * 1024u + (unsigned)(r & 255) * 1024u;
                    ((float*)(P.ws + WS_RGATE))[(size_t)e * T + r] = 0.f;
                }
            }
            __syncthreads();
        }
        PH(7)
        {
            LOADP;
            eg::MoeSched<2, true, false> S; S.abytes = 0; S.A = (const char*)(P.ws + WS_H1L); S.W = (const char*)(P.ws + WS_WGU);   S.lst = list; S.cnts = count; S.gcum = prefix; S.rdst = nullptr; S.ntiles = ntiles; S.G = G; S.c = bid;
            S.wstride_e = (size_t)2 * 256 * 1024; S.wstride_sub = (size_t)256 * 1024;
            u16* hbp = hbuf;
            eg::gemm_stream<1, true, 8>(1024, 1024, S, [&](const f32x4 (&acc)[2][2][4][2], const eg::MoeUnit& u, int wr, int wc, int fr, int fq, const LAS unsigned*) {
#pragma unroll
                for (int ai = 0; ai < 2; ++ai)
#pragma unroll
                    for (int m = 0; m < 4; ++m) {
                        unsigned char* rowp = (unsigned char*)hbp + ((size_t)u.tile * 256 + ai * 128 + wr * 64 + m * 16 + fr) * 256 + u.sub * 128 + wc * 32 + 8 * fq;
                        u32x2 p;
#pragma unroll
                        for (int n = 0; n < 2; ++n) {
                            const f32x4 Gv = acc[ai][0][m][n], Uv = acc[ai][1][m][n];
                            f32x2 h2[2];
#pragma unroll
                            for (int hh = 0; hh < 2; ++hh) {
                                const f32x2 G2 = {Gv[2 * hh], Gv[2 * hh + 1]}, U2 = {Uv[2 * hh], Uv[2 * hh + 1]};
                                const f32x2 t2 = G2 * (-1.44269504088896341f / 64.0f);
                                const f32x2 d2 = (f32x2){__builtin_amdgcn_exp2f(t2[0]), __builtin_amdgcn_exp2f(t2[1])} + 1.0f;
                                const f32x2 r2 = {__builtin_amdgcn_rcpf(d2[0]), __builtin_amdgcn_rcpf(d2[1])};
                                h2[hh] = (G2 * (1.0f / 1024.0f)) * U2 * r2;
                            }
                            p[n] = (unsigned)__builtin_amdgcn_cvt_pk_fp8_f32(h2[1][0], h2[1][1], __builtin_amdgcn_cvt_pk_fp8_f32(h2[0][0], h2[0][1], 0, false), true);
                        }
                        *(u32x2*)rowp = p;
                    }
            });
        }
        GRID_SYNC();
        PH(8)
        {
            LOADP;
            eg::MoeSched<4, false, true> S; S.A = (const char*)hbuf; S.W = (const char*)(P.ws + WS_WD); S.abytes = 256 * 256; S.lst = list; S.cnts = count; S.gcum = prefix; S.rdst = (const unsigned*)(P.ws + WS_RDST);
            S.ntiles = ntiles; S.G = G; S.c = bid; S.wstride_e = (size_t)1024 * 256; S.wstride_sub = (size_t)256 * 256;
            u16* sl = slots;
            eg::gemm_stream<2, true, 8>(256, 256, S, [&](const f32x4 (&acc)[2][2][4][2], const eg::MoeUnit& u, int wr, int wc, int fr, int fq, const LAS unsigned* ri) {
                LAS unsigned char* eb = (LAS unsigned char*)(smem + eg::EG_EPB);
                const int waddr = (wr * 16 + fr) * 256 + (((wc * 4 + fq) ^ fr) << 4);
                const int rrow = (wr * 4 + wc) * 4 + fq;
                const int raddr = rrow * 256 + ((fr ^ (rrow & 15)) << 4);
                const int rurow = (rrow >> 4) * 64 + (rrow & 15);
                unsigned char* sbase = (unsigned char*)sl + (unsigned)(u.sub * 256 + fr * 16);
#pragma unroll
                for (int ai = 0; ai < 2; ++ai)
#pragma unroll
                    for (int m = 0; m < 4; ++m) {
                        const int row = ai * 128 + wr * 64 + m * 16 + fr;
                        const float gt = __uint_as_float(ri[256 + row]);
                        const float g16 = gt * (16.0f / 256.0f);
                        u32x4 p;
#pragma unroll
                        for (int bj = 0; bj < 2; ++bj) {
                            const f32x4 v0 = acc[ai][bj][m][0] * g16, v1 = acc[ai][bj][m][1] * g16;
                            p[2 * bj] = (unsigned)__builtin_amdgcn_cvt_pk_fp8_f32(v0[2], v0[3], __builtin_amdgcn_cvt_pk_fp8_f32(v0[0], v0[1], 0, false), true);
                            p[2 * bj + 1] = (unsigned)__builtin_amdgcn_cvt_pk_fp8_f32(v1[2], v1[3], __builtin_amdgcn_cvt_pk_fp8_f32(v1[0], v1[1], 0, false), true);
                        }
                        const int bo = (m & 1) * 8192;
                        *(LAS u32x4*)(eb + bo + waddr) = p;
                        asm volatile("s_waitcnt lgkmcnt(0)" ::: "memory");
                        __builtin_amdgcn_s_barrier();
                        const u32x4 v = *(const LAS u32x4*)(eb + bo + raddr);
                        const unsigned dst = ri[ai * 128 + m * 16 + rurow];
                        *(u32x4*)(sbase + dst) = v;
                    }
            });
        }
        GRID_SYNC();
        PH(9)
        {
            LOADP;
            const int t = tid_opaque(), lane = t & 63, wave = t >> 6; (void)t;
            float* outp = (l == DEPTH - 1) ? P.out : (float*)nullptr;
            for (int tok0 = (bid * 8 + wave) * 2; tok0 < T; tok0 += G * 8 * 2) {
                ln_tokens<2>([&](int q) { return (const u16*)h1b + (size_t)(tok0 + q) * 1024; },
                    [&](int q, int c) {
                        const unsigned char* srow = (const unsigned char*)slots + (size_t)(tok0 + q) * 9 * 1024;
                        f32x2 a0 = {0.f, 0.f}, a1 = a0, a2 = a0, a3 = a0;
#pragma unroll
                        for (int k = 0; k < 9; ++k) {
                            const u32x2 v = *(const u32x2*)(srow + k * 1024 + c);
                            a0 += __builtin_amdgcn_cvt_pk_f32_fp8((int)v[0], false); a1 += __builtin_amdgcn_cvt_pk_f32_fp8((int)v[0], true);
                            a2 += __builtin_amdgcn_cvt_pk_f32_fp8((int)v[1], false); a3 += __builtin_amdgcn_cvt_pk_f32_fp8((int)v[1], true);
                        }
                        a0 = a0 * 0.0625f; a1 = a1 * 0.0625f; a2 = a2 * 0.0625f; a3 = a3 * 0.0625f;
                        F8 s; s.lo = (f32x4){a0[0], a0[1], a1[0], a1[1]}; s.hi = (f32x4){a2[0], a2[1], a3[0], a3[1]};
                        return s;
                    },
                    P.ln2g + l * 1024, P.ln2b + l * 1024,
                    [&](int q, int c, const f32x4 y0, const f32x4 y1) {
                        if (outp) { *(f32x4*)(outp + (size_t)(tok0 + q) * 1024 + c) = y0; *(f32x4*)(outp + (size_t)(tok0 + q) * 1024 + c + 4) = y1; }
                        else { u32x4 p; p[0] = pack2(y0[0], y0[1]); p[1] = pack2(y0[2], y0[3]); p[2] = pack2(y1[0], y1[1]); p[3] = pack2(y1[2], y1[3]); *(u32x4*)(hb + (size_t)(tok0 + q) * 1024 + c) = p; }
                    }, lane);
            }
        }
        GRID_SYNC();
    };
    layer_body(0);
    layer_body(1);
}
#undef qkv
#undef obuf
#undef mix
#undef h1
#undef hcur
#undef logits
#undef gatebuf
#undef list
#undef hbuf
#undef slots
#undef hb
#undef h1b
#undef h1l
#undef hin
#undef count
}

extern "C" void kernel_launch(void* const* d_in, const int* in_sizes, int n_in, void* d_out, int out_size, void* d_ws, size_t ws_size, hipStream_t stream) {
    static int grid = 0;
    if (grid == 0) {
        if (n_in != 19 || ws_size < WS_END) { fprintf(stderr, "kernel_launch: unexpected n_in %d or ws_size %zu < %zu\n", n_in, ws_size, (size_t)WS_END); grid = -1; return; }
        int dev = 0, cus = 0, per_cu = 0;
        hipGetDevice(&dev);
        hipDeviceGetAttribute(&cus, hipDeviceAttributeMultiprocessorCount, dev);
        if (hipFuncSetAttribute((const void*)fwd_kernel, hipFuncAttributeMaxDynamicSharedMemorySize, LDS_BYTES) != hipSuccess) { fprintf(stderr, "hipFuncSetAttribute failed\n"); grid = -1; return; }
        hipOccupancyMaxActiveBlocksPerMultiprocessor(&per_cu, (const void*)fwd_kernel, NTHREADS, LDS_BYTES);
        if (per_cu < 1) { fprintf(stderr, "occupancy query says %d\n", per_cu); }
        grid = cus > 0 ? cus : 256;
    }
    if (grid < 0) return;
    hipMemsetAsync((char*)d_ws + WS_CTL, 0, CTL_BYTES, stream);
    Params p{};
    p.x = (const float*)d_in[0]; p.w_in = (const float*)d_in[1]; p.w_out = (const float*)d_in[2]; p.rel = (const float*)d_in[3]; p.lbl = (const float*)d_in[4];
    p.hg = (const float*)d_in[5]; p.sinks = (const float*)d_in[6]; p.ln1g = (const float*)d_in[7]; p.ln1b = (const float*)d_in[8]; p.rw = (const float*)d_in[9];
    p.rb = (const float*)d_in[10]; p.wg = (const float*)d_in[11]; p.wu = (const float*)d_in[12]; p.wd = (const float*)d_in[13]; p.sg = (const float*)d_in[14];
    p.su = (const float*)d_in[15]; p.sd = (const float*)d_in[16]; p.ln2g = (const float*)d_in[17]; p.ln2b = (const float*)d_in[18];
    p.out = (float*)d_out; p.ws = (char*)d_ws;
    hipLaunchKernelGGL(fwd_kernel, dim3(grid), dim3(NTHREADS), LDS_BYTES, stream, p);
}
```

```cpp
#include <hip/hip_runtime.h>
#include <cstdio>
#include <cstdint>

#define XB_TMO      128
#define XB_XCNT(j)  (256  + 64 * (j))
#define XB_XSUB(j)  (1280 + 64 * (j))
#define XB_XGEN(j)  (2304 + 64 * (j))
#define XB_TOP      3328
#define XB_TOPGEN   3392
#define XCD_BAR_WORDS 3456
#define XB_SPIN_CAP (1u << 23)
#define LAS __attribute__((address_space(3)))

__device__ __forceinline__ unsigned xb_ld(unsigned* p)              { return __hip_atomic_load(p, __ATOMIC_RELAXED, __HIP_MEMORY_SCOPE_AGENT); }
__device__ __forceinline__ unsigned xb_add(unsigned* p, unsigned v) { return __hip_atomic_fetch_add(p, v, __ATOMIC_RELAXED, __HIP_MEMORY_SCOPE_AGENT); }
__device__ __forceinline__ unsigned xb_xcc_id() { return (unsigned)__builtin_amdgcn_s_getreg((3 << 11) | 20) & 0xFu; }
#define XB_SPIN(cond, bar) do { unsigned _sp = 0; while (cond) { __builtin_amdgcn_s_sleep(1); \
    if ((++_sp & 255u) == 0u) { if (xb_ld(&(bar)[XB_TMO])) break; if (_sp > XB_SPIN_CAP) { atomicAdd(&(bar)[XB_TMO], 1u); break; } } } } while (0)

struct XcdBarrier { unsigned* bar; unsigned x; volatile LAS unsigned* st; };

__device__ __forceinline__ XcdBarrier xcd_barrier_post(unsigned* bar, volatile LAS unsigned* st) {
    XcdBarrier b; b.bar = bar; b.x = xb_xcc_id(); b.st = st;
    if (threadIdx.x == 0) (void)xb_add(&bar[XB_XCNT(b.x)], 1u);
    return b;
}
__device__ __forceinline__ void xcd_barrier_complete(unsigned* bar, unsigned x, unsigned& nloc, unsigned& nx) {
    const unsigned G = gridDim.x * gridDim.y * gridDim.z;
    unsigned sum, cnt, mine, sp = 0u;
    for (;;) {
        sum = 0u; cnt = 0u; mine = 0u;
#pragma unroll
        for (unsigned j = 0; j < 16; ++j) { const unsigned c = xb_ld(&bar[XB_XCNT(j)]); sum += c; cnt += (c > 0u) ? 1u : 0u; mine = (j == x) ? c : mine; }
        if (sum == G) break;
        __builtin_amdgcn_s_sleep(1);
        if ((++sp & 255u) == 0u) { if (xb_ld(&bar[XB_TMO])) break; if (sp > XB_SPIN_CAP) { atomicAdd(&bar[XB_TMO], 1u); break; } }
    }
    nloc = mine > 0u ? mine : 1u; nx = cnt > 0u ? cnt : 1u;
}
__device__ __forceinline__ void xcd_barrier(const XcdBarrier& b) {
    asm volatile("s_waitcnt vmcnt(0)" ::: "memory");
    __syncthreads();
    if (threadIdx.x == 0) {
        unsigned* bar = b.bar;
        __builtin_amdgcn_s_waitcnt(0);
        unsigned nloc = b.st[0], nx = b.st[1];
        if (nloc == 0u) { xcd_barrier_complete(bar, b.x, nloc, nx); b.st[0] = nloc; b.st[1] = nx; }
        const unsigned old = xb_add(&bar[XB_XSUB(b.x)], 1u);
        const unsigned gen = old / nloc;
        if (old + 1u == (gen + 1u) * nloc) {
            __builtin_amdgcn_fence(__ATOMIC_RELEASE, "agent");
            asm volatile("s_waitcnt vmcnt(0)" ::: "memory");
            const unsigned og = xb_add(&bar[XB_TOP], 1u);
            const unsigned tg = og / nx;
            if (og + 1u == (tg + 1u) * nx) xb_add(&bar[XB_TOPGEN], 1u);
            else XB_SPIN(xb_ld(&bar[XB_TOPGEN]) == tg, bar);
            __builtin_amdgcn_fence(__ATOMIC_ACQUIRE, "agent");
            xb_add(&bar[XB_XGEN(b.x)], 1u);
            asm volatile("s_waitcnt vmcnt(0)" ::: "memory");
        } else {
            XB_SPIN(xb_ld(&bar[XB_XGEN(b.x)]) == gen, bar);
            __builtin_amdgcn_fence(__ATOMIC_ACQUIRE, "agent");
            asm volatile("s_waitcnt vmcnt(0)" ::: "memory");
        }
    }
    __syncthreads();
}

typedef unsigned short u16;
typedef short s16x4 __attribute__((ext_vector_type(4)));
typedef short s16x8 __attribute__((ext_vector_type(8)));
typedef float f32x2 __attribute__((ext_vector_type(2)));
typedef float f32x4 __attribute__((ext_vector_type(4)));
typedef float f32x16 __attribute__((ext_vector_type(16)));
typedef __bf16 bf16x2_t __attribute__((ext_vector_type(2)));
typedef unsigned u32x4 __attribute__((ext_vector_type(4)));
typedef unsigned u32x2 __attribute__((ext_vector_type(2)));

#ifndef PHASE_MASK
#define PHASE_MASK 0xFFFF
#endif
#ifndef REPMASK
#define REPMASK 0
#endif
#define PH(k) if ((PHASE_MASK >> (k)) & 1) for (int rep_ = 0; rep_ < (((REPMASK >> (k)) & 1) ? 2 : 1); ++rep_)
namespace {
constexpr int T = 32768, D = 1024, SEQ = 8192, NBATCH = 4, DEPTH = 2;
constexpr int INW = 3456;
constexpr int NE = 256, FF = 256;
constexpr int NTHREADS = 512;
constexpr float ALPHA = 1.41421356237309515f;
constexpr float LN_EPS = 1e-5f;
constexpr float MASKV = -1e30f;

constexpr int C_AQ = 0, C_AK = 384, C_AV = 768, C_BQ = 1152, C_BF = 1664, C_BI = 2176, C_BG = 2560, C_CQ = 2944, C_CK = 3200, C_CV = 3328;

constexpr size_t al256(size_t x) { return (x + 255) & ~(size_t)255; }
constexpr size_t MB = 1048576;
constexpr size_t WS_CTL = 0, CTL_BYTES = 65536;
constexpr size_t CTL_COUNT_OFF = 16384;
constexpr size_t WS_OBUF = WS_CTL + CTL_BYTES;
constexpr size_t WS_H1 = WS_OBUF + 64 * MB;
constexpr size_t WS_HCUR = WS_H1 + 128 * MB;
constexpr size_t WS_GATE = WS_HCUR + 128 * MB;
constexpr size_t WS_LIST = WS_GATE + 1 * MB;
constexpr size_t WS_RDST = WS_LIST + 32 * MB;
constexpr size_t WS_RGATE = WS_RDST + 34 * MB;
constexpr size_t WS_HB = WS_RGATE + 34 * MB;
constexpr size_t WS_H1B = WS_HB + 64 * MB;
constexpr size_t WS_H1L = WS_H1B + 64 * MB;
constexpr size_t WS_WGU = WS_H1L + 64 * MB;
constexpr size_t WS_WD = WS_WGU + 257 * MB;
constexpr size_t WS_WIN = WS_WD + 257 * MB / 2 + MB / 2;
constexpr size_t WS_WOUT = WS_WIN + 14 * MB;
constexpr size_t WS_R1 = WS_WOUT + 4 * MB;
constexpr size_t WS_QKV = WS_R1;
constexpr size_t WS_AO = WS_QKV + 216 * MB;
constexpr size_t WS_LSE = WS_AO + 144 * MB;
constexpr size_t WS_BRAW = WS_LSE + 3 * MB;
constexpr size_t WS_QG = WS_BRAW + 48 * MB;
constexpr size_t WS_SG = WS_QG + 32 * MB;
constexpr size_t WS_DG = WS_SG + 12 * MB;
constexpr size_t WS_MIX = WS_R1;
constexpr size_t WS_LOGITS = WS_R1 + 128 * MB;
constexpr int MAXTILES = 1280 + 128;
constexpr size_t WS_HBUF = WS_R1;
constexpr size_t WS_SLOTS = WS_HBUF + 176 * MB;
constexpr size_t WS_END = WS_SLOTS + 576 * MB;
static_assert(WS_DG + MB <= WS_END, "ws");
static_assert(WS_END <= (size_t)2048 * MB, "ws too big");

constexpr int LDS_HDR = 2048;
constexpr int LDS_PREFIX = 64;
constexpr int LDS_BYTES = 159744;

struct Params {
    const float* x; const float* w_in; const float* w_out; const float* rel; const float* lbl; const float* hg; const float* sinks;
    const float* ln1g; const float* ln1b; const float* rw; const float* rb; const float* wg; const float* wu; const float* wd;
    const float* sg; const float* su; const float* sd; const float* ln2g; const float* ln2b;
    float* out; char* ws;
};

__device__ __forceinline__ unsigned pack2(float a, float b) { bf16x2_t p = __builtin_convertvector((f32x2){a, b}, bf16x2_t); return __builtin_bit_cast(unsigned, p); }
__device__ __forceinline__ u16 f2bf(float a) { __bf16 h = (__bf16)a; return __builtin_bit_cast(u16, h); }
__device__ __forceinline__ float bf2f(u16 v) { return __uint_as_float(((unsigned)v) << 16); }
__device__ __forceinline__ float bfround(float a) { return bf2f(f2bf(a)); }
__device__ __forceinline__ float rmax(float a, float b) { float r; asm("v_max_f32 %0, %1, %2" : "=v"(r) : "v"(a), "v"(b)); return r; }
__device__ __forceinline__ float rmin(float a, float b) { float r; asm("v_min_f32 %0, %1, %2" : "=v"(r) : "v"(a), "v"(b)); return r; }
__device__ __forceinline__ float sigmoidf_(float x) { return 1.0f / (1.0f + __expf(-x)); }
__device__ __forceinline__ float fsigmoid(float x) { return __builtin_amdgcn_rcpf(1.0f + __builtin_amdgcn_exp2f(x * -1.44269504088896341f)); }

template <int CTRL> __device__ __forceinline__ float dpp_f(float v) { return __int_as_float(__builtin_amdgcn_update_dpp(__float_as_int(v), __float_as_int(v), CTRL, 0xF, 0xF, true)); }
template <int O> __device__ __forceinline__ float xshfl(float v) {
    if constexpr (O == 1) return __int_as_float(__builtin_amdgcn_update_dpp(__float_as_int(v), __float_as_int(v), 0xB1, 0xF, 0xF, true));
    else if constexpr (O == 2) return __int_as_float(__builtin_amdgcn_update_dpp(__float_as_int(v), __float_as_int(v), 0x4E, 0xF, 0xF, true));
    else if constexpr (O == 16) { auto r = __builtin_amdgcn_permlane16_swap(__float_as_uint(v), __float_as_uint(v), false, false); return __uint_as_float(r[0] ^ r[1] ^ __float_as_uint(v)); }
    else if constexpr (O == 32) { auto r = __builtin_amdgcn_permlane32_swap(__float_as_uint(v), __float_as_uint(v), false, false); return __uint_as_float(r[0] ^ r[1] ^ __float_as_uint(v)); }
    else return __int_as_float(__builtin_amdgcn_ds_swizzle(__float_as_int(v), (O << 10) | 0x1F));
}
template <int O> __device__ __forceinline__ int xshfl_i(int v) { return __float_as_int(xshfl<O>(__int_as_float(v))); }
template <int CTRL> __device__ __forceinline__ unsigned dpp_u(unsigned v) { return (unsigned)__builtin_amdgcn_update_dpp(0, (int)v, CTRL, 0xF, 0xF, true); }
__device__ __forceinline__ float wave_sum(float v) {
    v += xshfl<1>(v); v += xshfl<2>(v); v += dpp_f<0x141>(v); v += dpp_f<0x140>(v); v += xshfl<16>(v); v += xshfl<32>(v);
    return v;
}

extern __shared__ __attribute__((aligned(16))) char smem[];
__device__ __forceinline__ int tid_opaque() { int t = threadIdx.x; asm volatile("" : "+v"(t)); return t; }

constexpr int G_ASTR = 144, G_BSTR = 320;
constexpr int G_ABYTES = 256 * G_ASTR, G_BBYTES = 64 * G_BSTR, G_STAGE = G_ABYTES + G_BBYTES;
static_assert(LDS_HDR + 2 * G_STAGE <= LDS_BYTES, "lds");

template <int SPLIT, class AOff, class BPtr, class Epi>
__device__ __forceinline__ void gemm_tile(const u16* Ahi, const u16* Alo, int K, int ldb, AOff aoff, BPtr bptr, Epi epi) {
    const int t = tid_opaque(), lane = t & 63, wave = t >> 6, wr = wave >> 1, wc = wave & 1;
    const int nk = K >> 6, nsteps = SPLIT ? 3 * nk : nk;
    unsigned aoffs[4];
#pragma unroll
    for (int i = 0; i < 4; ++i) aoffs[i] = aoff((t >> 3) + 64 * i) + (t & 7) * 8;
    const float* bp = bptr((t & 31) * 4) + (size_t)(t >> 5) * ldb;
    uint4 rab[4]; f32x4 rb[4];
    auto gload = [&](int step) {
        const int kt = SPLIT ? (step % nk) : step;
        const u16* Ab = (SPLIT && step >= 2 * nk) ? Alo : Ahi;
#pragma unroll
        for (int i = 0; i < 4; ++i) rab[i] = *(const uint4*)(Ab + aoffs[i] + kt * 64);
#pragma unroll
        for (int i = 0; i < 4; ++i) rb[i] = *(const f32x4*)(bp + (size_t)(kt * 64 + 16 * i) * ldb);
    };
    auto lwrite = [&](int step, int buf) {
        const bool blo = SPLIT && (step >= nk) && (step < 2 * nk);
        const int ab = LDS_HDR + buf * G_STAGE, bb = ab + G_ABYTES;
#pragma unroll
        for (int i = 0; i < 4; ++i) *(uint4*)(smem + ab + ((t >> 3) + 64 * i) * G_ASTR + (t & 7) * 16) = rab[i];
#pragma unroll
        for (int i = 0; i < 4; ++i) {
            f32x4 v = rb[i];
            if (blo) { v[0] -= bfround(v[0]); v[1] -= bfround(v[1]); v[2] -= bfround(v[2]); v[3] -= bfround(v[3]); }
            uint2 p; p.x = pack2(v[0], v[1]); p.y = pack2(v[2], v[3]);
            *(uint2*)(smem + bb + ((t >> 5) + 16 * i) * G_BSTR + (t & 31) * 8) = p;
        }
    };
    f32x16 acc[2][2];
#pragma unroll
    for (int m = 0; m < 2; ++m)
#pragma unroll
        for (int n = 0; n < 2; ++n)
#pragma unroll
            for (int r = 0; r < 16; ++r) acc[m][n][r] = 0.f;
    const int a_rd = (wr * 64 + (lane & 31)) * G_ASTR + (lane >> 5) * 16;
    const int b_rd = ((lane >> 5) * 8 + ((lane & 15) >> 2)) * G_BSTR + (wc * 64 + 16 * ((lane >> 4) & 1) + 4 * (lane & 3)) * 2;
    gload(0);
    lwrite(0, 0);
    __syncthreads();
    for (int s = 0; s < nsteps; ++s) {
        const int buf = s & 1;
        if (s + 1 < nsteps) gload(s + 1);
        const int ab = LDS_HDR + buf * G_STAGE, bb = ab + G_ABYTES;
#pragma unroll
        for (int kk = 0; kk < 4; ++kk) {
            s16x8 af[2], bf[2];
#pragma unroll
            for (int m = 0; m < 2; ++m) af[m] = *(const s16x8*)(smem + ab + a_rd + m * 32 * G_ASTR + kk * 32);
#pragma unroll
            for (int n = 0; n < 2; ++n) {
                const int o = bb + b_rd + kk * 16 * G_BSTR + n * 64;
                s16x4 lo = __builtin_amdgcn_ds_read_tr16_b64_v4i16((LAS s16x4*)(smem + o));
                s16x4 hi = __builtin_amdgcn_ds_read_tr16_b64_v4i16((LAS s16x4*)(smem + o + 4 * G_BSTR));
                bf[n] = (s16x8){lo[0], lo[1], lo[2], lo[3], hi[0], hi[1], hi[2], hi[3]};
            }
#pragma unroll
            for (int m = 0; m < 2; ++m)
#pragma unroll
                for (int n = 0; n < 2; ++n) acc[m][n] = __builtin_amdgcn_mfma_f32_32x32x16_bf16(af[m], bf[n], acc[m][n], 0, 0, 0);
        }
        if (s + 1 < nsteps) lwrite(s + 1, buf ^ 1);
        __syncthreads();
    }
    epi(acc, wr, wc, lane);
}
#define CROW(m, r) (wr * 64 + (m) * 32 + ((r) & 3) + 8 * ((r) >> 2) + 4 * (lane >> 5))
#define CCOL(n) (wc * 64 + (n) * 32 + (lane & 31))

namespace eg {
constexpr int BM = 256, BK = 64, HALF = 128, HTB = HALF * BK * 2, STAGE_BYTES = 8 * HTB, NXCD = 8, WGM = 8;
static_assert(LDS_HDR + STAGE_BYTES <= LDS_BYTES, "lds eg");
__device__ __forceinline__ int lds_byte(int r, int c) { const int st = (r >> 4) * 2 + (c >> 5), rr = r & 15, cc = c & 31, ob = rr * 64 + cc * 2; return st * 1024 + (ob ^ (((ob >> 9) & 1) << 5)); }
__device__ __forceinline__ void stage_rc(int b, int& R, int& C) { const int st = b / 1024, sb = b % 1024, swz = sb ^ (((sb >> 9) & 1) << 5); R = (st >> 1) * 16 + swz / 64; C = (st & 1) * 32 + (swz % 64) / 2; }
typedef short bf16x8 __attribute__((ext_vector_type(8)));

__device__ __forceinline__ int perm32(int rho) { const int n = rho >> 4, i = rho & 15; return 8 * (i >> 2) + 4 * n + (i & 3); }
__device__ __forceinline__ int perm64(int R) { return 64 * (R >> 5) + 16 * ((R >> 2) & 3) + 4 * ((R >> 4) & 1) + (R & 3); }
constexpr int EG_RI = LDS_HDR + STAGE_BYTES;
constexpr int EG_TAB = EG_RI + 4096;
constexpr int EG_EPB = EG_TAB + 1408 * 4;
static_assert(EG_EPB + 16384 <= LDS_BYTES, "lds ri");
typedef int i32x8 __attribute__((ext_vector_type(8)));
__device__ __forceinline__ void stage_rc8(int b, int& R, int& Cb) {
    const int h = b >> 13, r = (b >> 6) & 127, cp = (b >> 4) & 3;
    const int p = (0x78 >> (2 * (cp ^ ((r >> 2) & 3)))) & 3;
    R = r; Cb = p * 32 + h * 16;
}
template <int PERM, bool FP8, int NST, class Sched, class Epi>
__device__ __forceinline__ void gemm_stream(int Kb, int ldaB, const Sched& S, const Epi& E) {
    typedef typename Sched::Unit Unit;
    LAS unsigned char* lds = (LAS unsigned char*)(smem + LDS_HDR);
    const int tid = tid_opaque(), wid = __builtin_amdgcn_readfirstlane(tid >> 6), lane = tid & 63, wr = wid >> 2, wc = wid & 3, fr = lane & 15, fq = lane >> 4;
    const int nt = Kb / 128;
    unsigned voffB[2]; unsigned vA0[2], vA1[2];
    Unit cur, nxt; int ui = 0;
    if (!S.next(0, cur)) return;
    auto stage_map = [&](int b, int& R, int& Cb) __attribute__((always_inline)) { if (FP8) stage_rc8(b, R, Cb); else { int C; stage_rc(b, R, C); Cb = C * 2; } };
    { int R0, C0, R1, C1; stage_map(tid * 16, R0, C0); stage_map(tid * 16 + 8192, R1, C1);
      vA0[0] = (unsigned)S.arow(cur, R0) * (unsigned)ldaB + C0; vA0[1] = (unsigned)S.arow(cur, R1) * (unsigned)ldaB + C1;
      if (Sched::DENSE_A) { vA1[0] = vA0[0]; vA1[1] = vA0[1]; }
      else { vA1[0] = (unsigned)S.arow(cur, 128 + R0) * (unsigned)ldaB + C0; vA1[1] = (unsigned)S.arow(cur, 128 + R1) * (unsigned)ldaB + C1; }
      const int Rb0 = PERM == 2 ? perm64(R0) : (PERM ? ((R0 & ~31) + perm32(R0 & 31)) : R0), Rb1 = PERM == 2 ? perm64(R1) : (PERM ? ((R1 & ~31) + perm32(R1 & 31)) : R1);
      voffB[0] = (unsigned)(Rb0 * Kb + C0); voffB[1] = (unsigned)(Rb1 * Kb + C1); }
    const size_t kstep = 128;
    const size_t hstep = (size_t)(PERM == 2 ? 8 : HALF) * Kb;
    const size_t hstepA = Sched::DENSE_A ? (size_t)HALF * ldaB : 0;
    const unsigned ldsw = (unsigned)wid * 1024u;
    const int gq = (0x9C >> (2 * fq)) & 3;
    const int aoff = FP8 ? ((wr * 64 + fr) * 64 + ((((fr >> 2) & 3) ^ gq) << 4)) : lds_byte(wr * 64 + fr, fq * 8);
    const int boff = FP8 ? ((wc * 32 + fr) * 64 + ((((fr >> 2) & 3) ^ gq) << 4)) : lds_byte(wc * 32 + fr, fq * 8);
    const unsigned lda2 = (unsigned)ldaB;
#define EG_SA(b, h) (((b) * 2 + (h)) * HTB)
#define EG_SB(b, h) ((4 + (b) * 2 + (h)) * HTB)
#define EG_STAGE(bufoff, gbase, voff) do { _Pragma("unroll") for (int _i = 0; _i < 2; ++_i) \
        __builtin_amdgcn_global_load_lds((const unsigned*)((const char*)(gbase) + (voff)[_i]), (LAS unsigned*)(lds + (bufoff) + ldsw + _i * 8192), 16, 0, 0); } while (0)
#define EG_LDA(dst, b, h) do { if constexpr (FP8) { _Pragma("unroll") for (int m = 0; m < 4; ++m) { const u32x4 l0_ = *(const LAS u32x4*)(lds + EG_SA(b, h) + aoff + m * 1024), l1_ = *(const LAS u32x4*)(lds + EG_SA(b, h) + aoff + m * 1024 + 8192); \
            dst##8[m] = __builtin_bit_cast(i32x8, __builtin_shufflevector(l0_, l1_, 0, 1, 2, 3, 4, 5, 6, 7)); } } \
        else { _Pragma("unroll") for (int m = 0; m < 4; ++m) _Pragma("unroll") for (int k = 0; k < 2; ++k) dst[m][k] = *(const LAS bf16x8*)(lds + EG_SA(b, h) + aoff + m * 2048 + k * 1024); } } while (0)
#define EG_LDB(dst, b, h) do { if constexpr (FP8) { _Pragma("unroll") for (int n = 0; n < 2; ++n) { const u32x4 l0_ = *(const LAS u32x4*)(lds + EG_SB(b, h) + boff + n * 1024), l1_ = *(const LAS u32x4*)(lds + EG_SB(b, h) + boff + n * 1024 + 8192); \
            dst##8[n] = __builtin_bit_cast(i32x8, __builtin_shufflevector(l0_, l1_, 0, 1, 2, 3, 4, 5, 6, 7)); } } \
        else { _Pragma("unroll") for (int n = 0; n < 2; ++n) _Pragma("unroll") for (int k = 0; k < 2; ++k) dst[n][k] = *(const LAS bf16x8*)(lds + EG_SB(b, h) + boff + n * 2048 + k * 1024); } } while (0)
#define EG_MMA(ai, bj, At, Bt) do { __builtin_amdgcn_s_setprio(1); if constexpr (FP8) { _Pragma("unroll") for (int m = 0; m < 4; ++m) _Pragma("unroll") for (int n = 0; n < 2; ++n) \
            acc[ai][bj][m][n] = __builtin_amdgcn_mfma_scale_f32_16x16x128_f8f6f4(Bt##8[n], At##8[m], acc[ai][bj][m][n], 0, 0, 0, 0, 0, 0); } \
        else { _Pragma("unroll") for (int m = 0; m < 4; ++m) _Pragma("unroll") for (int n = 0; n < 2; ++n) _Pragma("unroll") for (int k = 0; k < 2; ++k) \
            acc[ai][bj][m][n] = __builtin_amdgcn_mfma_f32_16x16x32_bf16(Bt[n][k], At[m][k], acc[ai][bj][m][n], 0, 0, 0); } __builtin_amdgcn_s_setprio(0); } while (0)
#define EG_WAIT_V(n) asm volatile("s_waitcnt vmcnt(" #n ")" ::: "memory")
#define EG_WAIT_L(n) asm volatile("s_waitcnt lgkmcnt(" #n ")" ::: "memory")
#define EG_WAIT_VR() do { if (NST > 0 && relax) asm volatile("s_waitcnt vmcnt(%0)" :: "n"(8 + NST + Sched::BEGIN_OPS) : "memory"); else asm volatile("s_waitcnt vmcnt(8)" ::: "memory"); } while (0)
#define EG_BAR __builtin_amdgcn_s_barrier()
#define EG_SCHED __builtin_amdgcn_sched_barrier(0)
    f32x4 acc[2][2][4][2];
#pragma unroll
    for (int a = 0; a < 2; ++a)
#pragma unroll
        for (int b = 0; b < 2; ++b)
#pragma unroll
            for (int m = 0; m < 4; ++m)
#pragma unroll
                for (int n = 0; n < 2; ++n) acc[a][b][m][n] = (f32x4){0.f, 0.f, 0.f, 0.f};
    bf16x8 At[4][2], B0[2][2], B1[2][2]; i32x8 At8[4], B08[2], B18[2];
    const char* cA = cur.A; const char* cB = cur.B;
    S.begin(cur, (LAS unsigned*)(smem + EG_RI), tid);
    EG_STAGE(EG_SB(0, 0), cB, voffB); EG_STAGE(EG_SB(0, 1), cB + hstep, voffB); EG_STAGE(EG_SA(0, 0), cA, vA0); EG_STAGE(EG_SA(0, 1), cA + hstepA, vA1);
    if (wr == 1) EG_BAR;
    EG_WAIT_V(2); EG_BAR;
    EG_STAGE(EG_SB(1, 0), cB + kstep, voffB); EG_STAGE(EG_SA(1, 0), cA + kstep, vA0); EG_STAGE(EG_SB(1, 1), cB + hstep + kstep, voffB);
    EG_WAIT_V(6); EG_BAR;
    for (;;) {
        const bool has_next = S.next(ui + 1, nxt);
        const char* nA = has_next ? nxt.A : cA; const char* nB = has_next ? nxt.B : cB;
        if (has_next) S.prefetch_rows(nxt, (LAS unsigned*)(smem + EG_RI + ((ui + 1) & 1) * 2048), tid);
#pragma unroll 1
        for (int t = 0; t < nt; t += 2) {
            const bool last = (t == nt - 2);
            const bool relax = (t == 0) && (ui > 0);
            const char* a1 = cA + (size_t)(t + 1) * kstep;
            const char* a2 = last ? nA : cA + (size_t)(t + 2) * kstep; const char* b2 = last ? nB : cB + (size_t)(t + 2) * kstep;
            const char* a3 = a2 + kstep; const char* b3 = b2 + kstep;
            EG_LDB(B0, 0, 0); EG_LDB(B1, 0, 1); EG_SCHED; EG_LDA(At, 0, 0); EG_STAGE(EG_SA(1, 1), a1 + hstepA, vA1);
            if (last && has_next) {
                int r0, c0, r1, c1; stage_map(tid * 16, r0, c0); stage_map(tid * 16 + 8192, r1, c1);
                const LAS unsigned* rl = (const LAS unsigned*)(smem + EG_RI + ((ui + 1) & 1) * 2048);
                vA0[0] = (unsigned)S.arow_lds(nxt, r0, rl) * lda2 + c0; vA0[1] = (unsigned)S.arow_lds(nxt, r1, rl) * lda2 + c1;
                if (Sched::DENSE_A) { vA1[0] = vA0[0]; vA1[1] = vA0[1]; }
                else { vA1[0] = (unsigned)S.arow_lds(nxt, 128 + r0, rl) * lda2 + c0; vA1[1] = (unsigned)S.arow_lds(nxt, 128 + r1, rl) * lda2 + c1; }
            }
            EG_WAIT_VR(); EG_WAIT_L(0); EG_BAR; EG_MMA(0, 0, At, B0); EG_MMA(0, 1, At, B1); EG_BAR; EG_SCHED;
            EG_LDA(At, 0, 1); EG_STAGE(EG_SB(0, 0), b2, voffB); EG_STAGE(EG_SB(0, 1), b2 + hstep, voffB); EG_STAGE(EG_SA(0, 0), a2, vA0);
            EG_WAIT_VR(); EG_WAIT_L(0); EG_BAR; if (!cur.half) { EG_MMA(1, 0, At, B0); EG_MMA(1, 1, At, B1); } EG_BAR; EG_SCHED;
            EG_LDB(B0, 1, 0); EG_LDB(B1, 1, 1); EG_SCHED; EG_LDA(At, 1, 0); EG_STAGE(EG_SA(0, 1), a2 + hstepA, vA1);
            EG_WAIT_V(8); EG_WAIT_L(0); EG_BAR; EG_MMA(0, 0, At, B0); EG_MMA(0, 1, At, B1); EG_BAR; EG_SCHED;
            EG_LDA(At, 1, 1); EG_STAGE(EG_SB(1, 0), b3, voffB); EG_STAGE(EG_SB(1, 1), b3 + hstep, voffB); EG_STAGE(EG_SA(1, 0), a3, vA0);
            EG_WAIT_V(8); EG_WAIT_L(0); EG_BAR; if (!cur.half) { EG_MMA(1, 0, At, B0); EG_MMA(1, 1, At, B1); } EG_BAR; EG_SCHED;
        }
        if (wr == 0) EG_BAR;
        E(acc, cur, wr, wc, fr, fq, (const LAS unsigned*)(smem + EG_RI + (ui & 1) * 2048));
        if (!has_next) break;
#pragma unroll
        for (int a = 0; a < 2; ++a)
#pragma unroll
            for (int b = 0; b < 2; ++b)
#pragma unroll
                for (int m = 0; m < 4; ++m)
#pragma unroll
                    for (int n = 0; n < 2; ++n) acc[a][b][m][n] = (f32x4){0.f, 0.f, 0.f, 0.f};
        cur = nxt; cA = nA; cB = nB; ++ui;
        S.begin(cur, (LAS unsigned*)(smem + EG_RI + (ui & 1) * 2048), tid);
        if (wr == 1) EG_BAR;
    }
    EG_WAIT_V(0);
    EG_BAR;
#undef EG_SA
#undef EG_SB
#undef EG_STAGE
#undef EG_LDA
#undef EG_LDB
#undef EG_MMA
#undef EG_WAIT_V
#undef EG_WAIT_L
#undef EG_WAIT_VR
#undef EG_BAR
#undef EG_SCHED
}

struct DenseUnit { const char* A; const char* B; int pm, pn; bool half; };
struct DenseSched {
    typedef DenseUnit Unit;
    static constexpr bool DENSE_A = true;
    static constexpr int BEGIN_OPS = 0;
    const char* A; const char* Bt; int K, nM, nN, nwg, G, c;
    __device__ __forceinline__ bool next(int i, Unit& u) const {
        const long L = (long)i * G + c; if (L >= nwg) return false;
        int wgid = (int)L; { const int q = nwg / NXCD, r = nwg % NXCD, xcd = wgid % NXCD, off = wgid / NXCD; wgid = (xcd < r ? xcd * (q + 1) : r * (q + 1) + (xcd - r) * q) + off; }
        const int nig = WGM * nN, gid = wgid / nig, fm = gid * WGM, gsz = (nM - fm) < WGM ? (nM - fm) : WGM;
        u.pm = fm + ((wgid % nig) % gsz); u.pn = (wgid % nig) / gsz;
        u.A = A; u.B = Bt + (size_t)u.pn * 256 * K * 2; u.half = false;
        return true;
    }
    __device__ __forceinline__ int arow(const Unit& u, int r) const { return u.pm * 256 + r; }
    __device__ __forceinline__ int arow_lds(const Unit& u, int r, const LAS unsigned*) const { return u.pm * 256 + r; }
    __device__ __forceinline__ void prefetch_rows(const Unit&, LAS unsigned*, int) const {}
    __device__ __forceinline__ void begin(const Unit&, LAS unsigned*, int) const {}
};

struct MoeUnit { const char* A; const char* B; int e, mt, cnt, tile, sub; bool half; };
template <int SUB, bool GATHER, bool ROWINFO>
struct MoeSched {
    typedef MoeUnit Unit;
    static constexpr bool DENSE_A = !GATHER;
    static constexpr int BEGIN_OPS = ROWINFO ? 1 : 0;
    const char* A; const char* W; const int* lst; const int* cnts; const int* gcum; const unsigned* rdst; int ntiles, G, c; size_t wstride_e, wstride_sub; int abytes;
    __device__ __forceinline__ bool next(int i, Unit& u) const {
        int tile, sub;
        if (G % (8 * SUB) == 0) { const int q = c & 7, j = c >> 3, per = G / (8 * SUB); tile = i * (G / SUB) + q * per + (j / SUB); sub = j % SUB; }
        else { const int L = i * G + c; tile = L / SUB; sub = L % SUB; }
        if (tile >= ntiles + 128) return false;
        u.tile = tile; u.sub = sub;
        if (tile < ntiles) {
            const unsigned pk = ((const unsigned*)(smem + EG_TAB))[tile];
            u.e = (int)(pk & 511u); u.mt = (int)((pk >> 9) & 127u); u.cnt = (int)(pk >> 16);
        } else { u.e = 256; u.mt = tile - ntiles; u.cnt = 256; }
        u.half = u.cnt <= 128;
        u.A = GATHER ? A : A + (size_t)tile * (size_t)abytes;
        u.B = W + (size_t)u.e * wstride_e + (size_t)u.sub * wstride_sub;
        return true;
    }
    __device__ __forceinline__ int arow(const Unit& u, int r) const {
        if (!GATHER) return r;
        if (u.e == 256) return u.mt * 256 + r;
        return r < u.cnt ? (lst[(size_t)u.e * T + u.mt * 256 + r] >> 3) : 0;
    }
    __device__ __forceinline__ int arow_lds(const Unit& u, int r, const LAS unsigned* rl) const {
        if (!GATHER) return r;
        if (u.e == 256) return u.mt * 256 + r;
        return r < u.cnt ? (int)(rl[r] >> 3) : 0;
    }
    __device__ __forceinline__ void prefetch_rows(const Unit& u, LAS unsigned* rl, int) const {
        const int tid = tid_opaque();
        if (GATHER && !ROWINFO) { if (tid < 256) __builtin_amdgcn_global_load_lds((const unsigned*)lst + (size_t)(u.e == 256 ? 0 : u.e) * T + u.mt * 256 + tid, rl + (tid & ~63), 4, 0, 0); }
    }
    __device__ __forceinline__ void begin(const Unit& u, LAS unsigned* ri, int) const {
        if (ROWINFO) {
            const int tid = tid_opaque();
            const unsigned* srcp = rdst + (size_t)(tid >> 8) * ((WS_RGATE - WS_RDST) / 4) + (size_t)u.e * T + u.mt * 256 + (tid & 255);
            __builtin_amdgcn_global_load_lds(srcp, ri + (tid & ~63), 4, 0, 0);
        }
    }
};
}

constexpr int CV_STR = 144;
template <class DstRow>
__device__ __forceinline__ void conv_block(const float* src, int ldsrc, int k0, int n0, u16* dst, DstRow dstrow) {
    const int t = tid_opaque();
#pragma unroll
    for (int i = 0; i < 4; ++i) {
        const int k = (t >> 5) + 16 * i, nq = t & 31;
        const f32x4 v = *(const f32x4*)(src + (size_t)(k0 + k) * ldsrc + n0 + nq * 4);
#pragma unroll
        for (int j = 0; j < 4; ++j) *(u16*)(smem + LDS_HDR + (nq * 4 + j) * CV_STR + k * 2) = f2bf(v[j]);
    }
    __syncthreads();
#pragma unroll
    for (int i = 0; i < 2; ++i) {
        const int n = (t >> 3) + 64 * i, c = t & 7;
        *(u32x4*)(dst + dstrow(n0 + n) + k0 + c * 8) = *(const u32x4*)(smem + LDS_HDR + n * CV_STR + c * 16);
    }
    __syncthreads();
}

struct CvDesc { const float* src; u16* dst; int ld, rs_hi, radd, dk; bool f8; };
template <class GetDesc>
__device__ __forceinline__ void conv_stream(int nblocks, int first, int stride, GetDesc getdesc) {
    const int t = tid_opaque(), kb = 8 * (t >> 6), nq = t & 63;
    if (first >= nblocks) return;
    constexpr int CVB = 256 * 128;
    CvDesc d[2]; f32x4 r[2][8]; bool hv[2];
#pragma unroll
    for (int b = 0; b < 2; ++b) {
        const int u = first + b * stride; hv[b] = u < nblocks; d[b] = getdesc(hv[b] ? u : first);
#pragma unroll
        for (int i = 0; i < 8; ++i) r[b][i] = *(const f32x4*)(d[b].src + (size_t)(kb + i) * d[b].ld + nq * 4);
    }
    for (int u0 = first; u0 < nblocks; u0 += 2 * stride) {
        CvDesc dn[2]; f32x4 rn[2][8]; bool hn[2];
#pragma unroll
        for (int b = 0; b < 2; ++b) {
            const int u = u0 + (2 + b) * stride; hn[b] = u < nblocks; dn[b] = getdesc(hn[b] ? u : first);
            if (hn[b]) {
#pragma unroll
                for (int i = 0; i < 8; ++i) rn[b][i] = *(const f32x4*)(dn[b].src + (size_t)(kb + i) * dn[b].ld + nq * 4);
            }
        }
#pragma unroll
        for (int b = 0; b < 2; ++b)
#pragma unroll
            for (int j = 0; j < 4; ++j) {
                u32x4 p; p[0] = pack2(r[b][0][j], r[b][1][j]); p[1] = pack2(r[b][2][j], r[b][3][j]); p[2] = pack2(r[b][4][j], r[b][5][j]); p[3] = pack2(r[b][6][j], r[b][7][j]);
                *(u32x4*)(smem + LDS_HDR + b * CVB + (nq * 4 + j) * 128 + (((t >> 6) ^ (nq & 7)) << 4)) = p;
            }
        __syncthreads();
#pragma unroll
        for (int b = 0; b < 2; ++b) {
            if (hv[b]) {
#pragma unroll
                for (int i = 0; i < 4; ++i) {
                    const int n = (t >> 3) + 64 * i, c = t & 7;
                    *(u32x4*)(d[b].dst + (size_t)((n >> 7) * d[b].rs_hi + d[b].radd + (n & 127)) * d[b].dk + c * 8) = *(const u32x4*)(smem + LDS_HDR + b * CVB + n * 128 + ((c ^ ((n >> 2) & 7)) << 4));
                }
            }
        }
        __syncthreads();
#pragma unroll
        for (int b = 0; b < 2; ++b) {
            d[b] = dn[b]; hv[b] = hn[b];
#pragma unroll
            for (int i = 0; i < 8; ++i) r[b][i] = rn[b][i];
        }
    }
}

template <class GetDesc>
__device__ __forceinline__ void conv_stream_dyn(int nblocks, unsigned* ctr, GetDesc getdesc) {
    const int t = tid_opaque(), kb = 8 * (t >> 6), nq = t & 63;
    constexpr int CVB = 256 * 128;
    volatile int* idxs = (volatile int*)(smem + 32);
    if (t == 0) { idxs[0] = (int)atomicAdd(ctr, 2u); idxs[1] = (int)atomicAdd(ctr, 2u); }
    __syncthreads();
    int cur = idxs[0], nxt = idxs[1];
    __syncthreads();
    if (cur >= nblocks) return;
    CvDesc d[2]; f32x4 r[2][8]; bool hv[2];
#pragma unroll
    for (int b = 0; b < 2; ++b) {
        const int u = cur + b; hv[b] = u < nblocks; d[b] = getdesc(hv[b] ? u : cur);
#pragma unroll
        for (int i = 0; i < 8; ++i) r[b][i] = *(const f32x4*)(d[b].src + (size_t)(kb + i) * d[b].ld + nq * 4);
    }
    for (int k = 0; cur < nblocks; ++k) {
        if (t == 0) idxs[k & 1] = (int)atomicAdd(ctr, 2u);
        CvDesc dn[2]; f32x4 rn[2][8]; bool hn[2];
#pragma unroll
        for (int b = 0; b < 2; ++b) {
            const int u = nxt + b; hn[b] = u < nblocks; dn[b] = getdesc(hn[b] ? u : cur);
            if (hn[b]) {
#pragma unroll
                for (int i = 0; i < 8; ++i) rn[b][i] = *(const f32x4*)(dn[b].src + (size_t)(kb + i) * dn[b].ld + nq * 4);
            }
        }
#pragma unroll
        for (int b = 0; b < 2; ++b) {
            if (d[b].f8) {
#pragma unroll
                for (int jj = 0; jj < 4; ++jj) {
                    u32x2 p;
                    p[0] = (unsigned)__builtin_amdgcn_cvt_pk_fp8_f32(64.f * r[b][2][jj], 64.f * r[b][3][jj], __builtin_amdgcn_cvt_pk_fp8_f32(64.f * r[b][0][jj], 64.f * r[b][1][jj], 0, false), true);
                    p[1] = (unsigned)__builtin_amdgcn_cvt_pk_fp8_f32(64.f * r[b][6][jj], 64.f * r[b][7][jj], __builtin_amdgcn_cvt_pk_fp8_f32(64.f * r[b][4][jj], 64.f * r[b][5][jj], 0, false), true);
                    *(u32x2*)(smem + LDS_HDR + b * CVB + (nq * 4 + jj) * 64 + (((t >> 6) ^ (nq & 7)) << 3)) = p;
                }
            } else {
#pragma unroll
                for (int jj = 0; jj < 4; ++jj) {
                    u32x4 p; p[0] = pack2(r[b][0][jj], r[b][1][jj]); p[1] = pack2(r[b][2][jj], r[b][3][jj]); p[2] = pack2(r[b][4][jj], r[b][5][jj]); p[3] = pack2(r[b][6][jj], r[b][7][jj]);
                    *(u32x4*)(smem + LDS_HDR + b * CVB + (nq * 4 + jj) * 128 + (((t >> 6) ^ (nq & 7)) << 4)) = p;
                }
            }
        }
        __syncthreads();
#pragma unroll
        for (int b = 0; b < 2; ++b) {
            if (hv[b]) {
                if (d[b].f8) {
#pragma unroll
                    for (int i = 0; i < 2; ++i) {
                        const int idx = t + NTHREADS * i, n = idx >> 2, c = idx & 3, sw = (n >> 2) & 7;
                        const u32x2 lo = *(const u32x2*)(smem + LDS_HDR + b * CVB + n * 64 + (((2 * c) ^ sw) << 3)), hi = *(const u32x2*)(smem + LDS_HDR + b * CVB + n * 64 + (((2 * c + 1) ^ sw) << 3));
                        *(u32x4*)((unsigned char*)d[b].dst + (size_t)((n >> 7) * d[b].rs_hi + d[b].radd + (n & 127)) * d[b].dk + c * 16) = (u32x4){lo[0], lo[1], hi[0], hi[1]};
                    }
                } else {
#pragma unroll
                    for (int i = 0; i < 4; ++i) {
                        const int n = (t >> 3) + 64 * i, c = t & 7;
                        *(u32x4*)(d[b].dst + (size_t)((n >> 7) * d[b].rs_hi + d[b].radd + (n & 127)) * d[b].dk + c * 8) = *(const u32x4*)(smem + LDS_HDR + b * CVB + n * 128 + ((c ^ ((n >> 2) & 7)) << 4));
                    }
                }
            }
        }
        __syncthreads();
        cur = nxt; nxt = idxs[k & 1];
#pragma unroll
        for (int b = 0; b < 2; ++b) {
            d[b] = dn[b]; hv[b] = hn[b];
#pragma unroll
            for (int i = 0; i < 8; ++i) r[b][i] = rn[b][i];
        }
    }
}

__device__ __forceinline__ int rel_bucket(int dist) {
    if (dist < 16) return dist;
    float lr = logf((float)dist / 16.0f) / 4.852030263919617f;
    int v = 16 + (int)(lr * 16.0f);
    return v < 31 ? v : 31;
}

constexpr int AT_BIAS = LDS_HDR, AT_Q = AT_BIAS + 1024, AT_QSTR = 144, AT_K = AT_Q + 128 * AT_QSTR, AT_V = AT_K + 256 * AT_QSTR, AT_VSTR = 192,
              AT_P = AT_V + 288 * AT_VSTR, AT_PSTR = 336, AT_END = AT_P + 8 * 16 * AT_PSTR;
static_assert(AT_END <= LDS_BYTES, "lds attn");

struct AUnit { int tok0, r, qb, qcol, kcol, vcol, maxd, relhead, pidx, head, mode; float sinkv; };
struct ARegs { u32x4 q[2], k[4], v[4]; float bias; };

template <int which>
__device__ __forceinline__ bool attn_decode(const Params& P, int l, int idx, AUnit& u) {
    if (which == 0) {
        if (idx >= 3072 + 1024) return false;
        if (idx < 3072) {
            const int p = 1 + idx / 1536, rem = idx % 1536, head = rem % 6, sb = rem / 6;
            const int r = (p == 1) ? 4 : 16, nblk = 64 / r;
            const int seq = sb / nblk, qb = sb % nblk, b = seq / r, res = seq % r;
            u.tok0 = b * SEQ + res; u.r = r; u.qb = qb; u.qcol = C_AQ + head * 64; u.kcol = C_AK + head * 64; u.vcol = C_AV + head * 64; u.maxd = 128; u.relhead = head;
            u.pidx = p - 1; u.head = head; u.mode = 0; u.sinkv = 0.f;
        } else {
            const int uc = idx - 3072, head = uc & 3, sb = uc >> 2, b = sb >> 6, qb = sb & 63;
            u.tok0 = b * SEQ; u.r = 1; u.qb = qb; u.qcol = C_CQ + head * 64; u.kcol = C_CK + (head >> 1) * 64; u.vcol = C_CV + (head >> 1) * 64; u.maxd = 127; u.relhead = 6 + head;
            u.pidx = 0; u.head = head; u.mode = 1; u.sinkv = P.sinks[l * 4 + head];
        }
    } else {
        if (idx >= 1536) return false;
        const int head = idx % 6, sb = idx / 6, b = sb >> 6, qb = sb & 63;
        u.tok0 = b * SEQ; u.r = 1; u.qb = qb; u.qcol = C_AQ + head * 64; u.kcol = C_AK + head * 64; u.vcol = C_AV + head * 64; u.maxd = 128; u.relhead = head;
        u.pidx = 0; u.head = head; u.mode = 2; u.sinkv = 0.f;
    }
    return true;
}

__device__ __forceinline__ void attn_gload(const Params& P, const AUnit& u, ARegs& R, int t) {
    const u16* qkv = (const u16*)(P.ws + WS_QKV);
    const int c = t & 7;
#pragma unroll
    for (int i = 0; i < 2; ++i) {
        const int row = (t >> 3) + 64 * i;
        const size_t tok = (size_t)u.tok0 + (size_t)u.r * (u.qb * 128 + row);
        R.q[i] = *(const u32x4*)(qkv + tok * INW + u.qcol + c * 8);
    }
#pragma unroll
    for (int i = 0; i < 4; ++i) {
        const int row = (t >> 3) + 64 * i;
        int pos = (u.qb - 1) * 128 + row; if (pos < 0) pos = row;
        const size_t tok = (size_t)u.tok0 + (size_t)u.r * pos;
        R.k[i] = *(const u32x4*)(qkv + tok * INW + u.kcol + c * 8);
        R.v[i] = *(const u32x4*)(qkv + tok * INW + u.vcol + c * 8);
    }
    { const int d = t < 129 ? t : 128; R.bias = P.rel[rel_bucket(d * u.r) * 10 + u.relhead] * 1.44269504088896341f; }
}
__device__ __forceinline__ void attn_lstore(const ARegs& R, int t) {
    const int c = t & 7;
#pragma unroll
    for (int i = 0; i < 2; ++i) *(u32x4*)(smem + AT_Q + ((t >> 3) + 64 * i) * AT_QSTR + c * 16) = R.q[i];
#pragma unroll
    for (int i = 0; i < 4; ++i) {
        const int row = (t >> 3) + 64 * i;
        *(u32x4*)(smem + AT_K + row * AT_QSTR + c * 16) = R.k[i];
        *(u32x4*)(smem + AT_V + row * AT_VSTR + c * 16) = R.v[i];
    }
    if (t < 132) ((float*)(smem + AT_BIAS))[t] = R.bias;
}

template <int which>
__device__ __forceinline__ void attn_compute(const Params& P, const AUnit& u, int t) {
    const int lane = t & 63, w = t >> 6, r = lane & 15, g = lane >> 4;
    const int qb = u.qb, maxd = u.maxd;
    const float sinkv = u.sinkv;
    const int mode = which == 1 ? 2 : u.mode;
    const bool has_sink = (mode == 1);
    const unsigned tokr = (unsigned)u.tok0 + (unsigned)u.r * (unsigned)(qb * 128 + 16 * w + r);
    u16* aob = (u16*)(P.ws + WS_AO);
    float* lsep = (float*)(P.ws + WS_LSE);
    u32x2 pa4[4], pa16[4]; float pl4 = 0.f, pl16 = 0.f;
    if (mode == 2) {
        pl4 = lsep[tokr * 6u + u.head]; pl16 = lsep[((unsigned)T + tokr) * 6u + u.head];
#pragma unroll
        for (int dt = 0; dt < 4; ++dt) {
            pa4[dt] = *(const u32x2*)(aob + tokr * 384u + u.head * 64 + dt * 16 + g * 4);
            pa16[dt] = *(const u32x2*)(aob + ((unsigned)T + tokr) * 384u + u.head * 64 + dt * 16 + g * 4);
        }
    }
    f32x4 sacc[9];
#pragma unroll
    for (int kt = 0; kt < 9; ++kt) sacc[kt] = (f32x4){0.f, 0.f, 0.f, 0.f};
    {
        s16x8 qa[2];
#pragma unroll
        for (int ks = 0; ks < 2; ++ks) qa[ks] = *(const s16x8*)(smem + AT_Q + (16 * w + r) * AT_QSTR + (32 * ks + 8 * g) * 2);
#pragma unroll
        for (int kt = 0; kt < 9; ++kt)
#pragma unroll
            for (int ks = 0; ks < 2; ++ks) {
                s16x8 kb = *(const s16x8*)(smem + AT_K + (16 * w + kt * 16 + r) * AT_QSTR + (32 * ks + 8 * g) * 2);
                sacc[kt] = __builtin_amdgcn_mfma_f32_16x16x32_bf16(kb, qa[ks], sacc[kt], 0, 0, 0);
                if (ks == 1 && (kt % 3) == 2) __builtin_amdgcn_sched_barrier(0);
            }
    }
    const float* bias = (const float*)(smem + AT_BIAS);
    constexpr float SC = 0.125f * 1.44269504088896341f;
    const float sink2 = sinkv * 1.44269504088896341f;
    const int dbase = 128 + r - g * 4;
    float mx = MASKV;
    if (qb > 0) {
#pragma unroll
        for (int kt = 0; kt < 9; ++kt)
#pragma unroll
            for (int j = 0; j < 4; ++j) {
                const int dist = dbase - 16 * kt - j;
                float v;
                if (kt >= 1 && kt <= 7) v = sacc[kt][j] * SC + bias[dist];
                else { const bool valid = (dist >= 0) && (dist <= maxd); const int dc = dist < 0 ? 0 : (dist > 128 ? 128 : dist); v = valid ? sacc[kt][j] * SC + bias[dc] : MASKV; }
                sacc[kt][j] = v;
                mx = fmaxf(mx, v);
            }
    } else {
#pragma unroll
        for (int kt = 0; kt < 9; ++kt)
#pragma unroll
            for (int j = 0; j < 4; ++j) {
                const int kl = kt * 16 + g * 4 + j;
                const int dist = 128 + r - kl;
                const int kpos = 16 * w + kl;
                const bool valid = (dist >= 0) && (dist <= maxd) && (kpos >= 128);
                const int dc = dist < 0 ? 0 : (dist > 128 ? 128 : dist);
                const float v = valid ? sacc[kt][j] * SC + bias[dc] : MASKV;
                sacc[kt][j] = v;
                mx = fmaxf(mx, v);
            }
    }
    mx = fmaxf(mx, xshfl<16>(mx)); mx = fmaxf(mx, xshfl<32>(mx));
    if (has_sink) mx = fmaxf(mx, sink2);
    float den = 0.f;
    const int pw = AT_P + w * 16 * AT_PSTR;
#pragma unroll
    for (int kt = 0; kt < 10; ++kt) {
        f32x4 p = {0.f, 0.f, 0.f, 0.f};
        if (kt < 9) {
#pragma unroll
            for (int j = 0; j < 4; ++j) { p[j] = __builtin_amdgcn_exp2f(sacc[kt < 9 ? kt : 0][j] - mx); den += p[j]; }
        }
        u32x2 pk; pk[0] = pack2(p[0], p[1]); pk[1] = pack2(p[2], p[3]);
        *(u32x2*)(smem + pw + r * AT_PSTR + (kt * 16 + g * 4) * 2) = pk;
    }
    den += xshfl<16>(den); den += xshfl<32>(den);
    if (has_sink) den += __builtin_amdgcn_exp2f(sink2 - mx);
    __builtin_amdgcn_fence(__ATOMIC_RELEASE, "workgroup");
    __builtin_amdgcn_wave_barrier();
    __builtin_amdgcn_fence(__ATOMIC_ACQUIRE, "workgroup");
    f32x4 oacc[4];
#pragma unroll
    for (int dt = 0; dt < 4; ++dt) oacc[dt] = (f32x4){0.f, 0.f, 0.f, 0.f};
#pragma unroll
    for (int ks = 0; ks < 5; ++ks) {
        s16x8 pa = *(const s16x8*)(smem + pw + r * AT_PSTR + (32 * ks + 8 * g) * 2);
#pragma unroll
        for (int dt = 0; dt < 4; ++dt) {
            const int o = AT_V + (16 * w + 32 * ks + 8 * g + (r >> 2)) * AT_VSTR + (dt * 16 + 4 * (lane & 3)) * 2;
            s16x4 lo = __builtin_amdgcn_ds_read_tr16_b64_v4i16((LAS s16x4*)(smem + o));
            s16x4 hi = __builtin_amdgcn_ds_read_tr16_b64_v4i16((LAS s16x4*)(smem + o + 4 * AT_VSTR));
            s16x8 vb = (s16x8){lo[0], lo[1], lo[2], lo[3], hi[0], hi[1], hi[2], hi[3]};
            oacc[dt] = __builtin_amdgcn_mfma_f32_16x16x32_bf16(vb, pa, oacc[dt], 0, 0, 0);
        }
    }
    const float inv = 1.0f / den;
    if (mode == 0) {
        u16* ao = aob + ((unsigned)u.pidx * (unsigned)T + tokr) * 384u + u.head * 64 + g * 4;
#pragma unroll
        for (int dt = 0; dt < 4; ++dt) { u32x2 pk; pk[0] = pack2(oacc[dt][0] * inv, oacc[dt][1] * inv); pk[1] = pack2(oacc[dt][2] * inv, oacc[dt][3] * inv); *(u32x2*)(ao + dt * 16) = pk; }
        if (g == 0) lsep[((unsigned)u.pidx * (unsigned)T + tokr) * 6u + u.head] = mx + __builtin_amdgcn_logf(den);
    } else if (mode == 1) {
        u16* ob = (u16*)(P.ws + WS_OBUF) + tokr * 1024u + 768 + u.head * 64 + g * 4;
#pragma unroll
        for (int dt = 0; dt < 4; ++dt) { u32x2 pk; pk[0] = pack2(oacc[dt][0] * inv, oacc[dt][1] * inv); pk[1] = pack2(oacc[dt][2] * inv, oacc[dt][3] * inv); *(u32x2*)(ob + dt * 16) = pk; }
    } else {
        const float l1 = mx + __builtin_amdgcn_logf(den);
        const float mm = fmaxf(l1, fmaxf(pl4, pl16));
        const float w1 = __builtin_amdgcn_exp2f(l1 - mm), w4 = __builtin_amdgcn_exp2f(pl4 - mm), w16 = __builtin_amdgcn_exp2f(pl16 - mm);
        const float wi = 1.0f / (w1 + w4 + w16);
        const float c1 = w1 * inv * wi, c4 = w4 * wi, c16 = w16 * wi;
        u16* ob = (u16*)(P.ws + WS_OBUF) + tokr * 1024u + u.head * 64 + g * 4;
#pragma unroll
        for (int dt = 0; dt < 4; ++dt) {
            const float a0 = __uint_as_float(pa4[dt][0] << 16), a1 = __uint_as_float(pa4[dt][0] & 0xffff0000u), a2 = __uint_as_float(pa4[dt][1] << 16), a3 = __uint_as_float(pa4[dt][1] & 0xffff0000u);
            const float b0 = __uint_as_float(pa16[dt][0] << 16), b1 = __uint_as_float(pa16[dt][0] & 0xffff0000u), b2 = __uint_as_float(pa16[dt][1] << 16), b3 = __uint_as_float(pa16[dt][1] & 0xffff0000u);
            u32x2 pk;
            pk[0] = pack2(c1 * oacc[dt][0] + c4 * a0 + c16 * b0, c1 * oacc[dt][1] + c4 * a1 + c16 * b1);
            pk[1] = pack2(c1 * oacc[dt][2] + c4 * a2 + c16 * b2, c1 * oacc[dt][3] + c4 * a3 + c16 * b3);
            *(u32x2*)(ob + dt * 16) = pk;
        }
    }
}

template <int which>
__device__ __forceinline__ void attn_phase(const Params& P, int l, int bid, int G) {
    const int t = tid_opaque();
    AUnit cur, nxt; ARegs R;
    int idx = bid;
    bool have = attn_decode<which>(P, l, idx, cur);
    if (have) attn_gload(P, cur, R, t);
    if (t < 256) *(u32x4*)(smem + AT_V + (256 + (t >> 3)) * AT_VSTR + (t & 7) * 16) = (u32x4){0u, 0u, 0u, 0u};
    while (have) {
        __syncthreads();
        attn_lstore(R, t);
        __syncthreads();
        idx += G;
        const bool hn = attn_decode<which>(P, l, idx, nxt);
        if (hn) attn_gload(P, nxt, R, t);
        attn_compute<which>(P, cur, t);
        cur = nxt; have = hn;
    }
    __syncthreads();
}

constexpr int HG_QS = 272, HG_QM = LDS_HDR, HG_KM = HG_QM + 64 * HG_QS, HG_KD = HG_KM + 64 * HG_QS, HG_QD = HG_KD + 64 * HG_QS,
              HG_I = HG_QD + 64 * HG_QS, HG_IS = 208, HG_P = HG_I + 64 * HG_IS, HG_PS = 144, HG_ST = HG_P + 64 * HG_PS, HG_PART = HG_ST + 96 * HG_QS,
              HG_DEC = HG_PART + 2048, HG_END = HG_DEC + 512;
static_assert(HG_END <= LDS_BYTES, "lds hgrn");

__device__ __forceinline__ void hgrn_group(const Params& P, int l, int b, int h, int g) {
    const int t = tid_opaque(), lane = t & 63, w = t >> 6;
    const int k = t & 127, tq = t >> 7;
    const u16* qkvp = (const u16*)(P.ws + WS_QKV);
    u16* qg = (u16*)(P.ws + WS_QG);
    float* ol = (float*)(P.ws + WS_BRAW);
    const int tok0 = b * SEQ + g * 512;
    float lb = 0.f;
    if (l == 1) lb = sigmoidf_(P.lbl[512 + h * 128 + k] - P.lbl[h * 128 + k]);
    const float om = 1.f - lb;
    float cumG = 0.f;
    f32x4 S[6];
#pragma unroll
    for (int i = 0; i < 6; ++i) S[i] = (f32x4){0.f, 0.f, 0.f, 0.f};
    for (int i = t; i < 96 * HG_QS / 16; i += NTHREADS) *(uint4*)(smem + HG_ST + i * 16) = make_uint4(0u, 0u, 0u, 0u);
    u16 rq[16], rf[16];
#pragma unroll
    for (int j = 0; j < 16; ++j) {
        const size_t tok = (size_t)tok0 + tq * 16 + j;
        rq[j] = qkvp[tok * INW + C_BQ + h * 128 + k]; rf[j] = qkvp[tok * INW + C_BF + h * 128 + k];
    }
    for (int c = 0; c < 8; ++c) {
        const int tokc = tok0 + c * 64;
#pragma unroll
        for (int i = 0; i < 2; ++i) {
            const int idx = t + i * NTHREADS;
            if (idx < 768) { const int row = idx / 12, cc = idx % 12;
                *(uint4*)(smem + HG_I + row * HG_IS + cc * 16) = *(const uint4*)(qkvp + (size_t)(tokc + row) * INW + C_BI + h * 96 + cc * 8); }
        }
        float qs[16], ky[16], cum[16];
        float run = 0.f;
#pragma unroll
        for (int j = 0; j < 16; ++j) {
            const float qv = bf2f(rq[j]), fv = bf2f(rf[j]);
            const float ee = __builtin_amdgcn_exp2f(fv * -1.44269504088896341f), sg = __builtin_amdgcn_rcpf(1.0f + ee);
            const float forget = lb + om * sg;
            run += __builtin_amdgcn_logf(forget) * 0.693147180559945309f;
            cum[j] = run; ky[j] = om * ee * sg; qs[j] = qv * fsigmoid(qv);
        }
        ((float*)(smem + HG_PART))[tq * 128 + k] = run;
        __syncthreads();
        if (c + 1 < 8) {
#pragma unroll
            for (int j = 0; j < 16; ++j) {
                const size_t tok = (size_t)tokc + 64 + tq * 16 + j;
                rq[j] = qkvp[tok * INW + C_BQ + h * 128 + k]; rf[j] = qkvp[tok * INW + C_BF + h * 128 + k];
            }
        }
        {
            const float* part = (const float*)(smem + HG_PART);
            const float p0 = part[k], p1 = part[128 + k], p2 = part[256 + k], p3 = part[384 + k];
            const float off = tq == 0 ? 0.f : (tq == 1 ? p0 : (tq == 2 ? p0 + p1 : p0 + p1 + p2));
            const float last = p0 + p1 + p2 + p3, cmid = p0 + p1;
            const float em = __expf(-cmid), eg = __expf(cumG);
#pragma unroll
            for (int j = 0; j < 16; ++j) {
                const float cu = off + cum[j];
                const int row = tq * 16 + j;
                const float qd = qs[j] * __expf(cu);
                *(u16*)(smem + HG_QM + row * HG_QS + k * 2) = f2bf(qd * em);
                *(u16*)(smem + HG_KM + row * HG_QS + k * 2) = f2bf(ky[j] * __expf(cmid - cu));
                *(u16*)(smem + HG_KD + row * HG_QS + k * 2) = f2bf(ky[j] * __expf(last - cu));
                *(u16*)(smem + HG_QD + row * HG_QS + k * 2) = f2bf(qd);
                qg[(size_t)(tokc + row) * 512 + h * 128 + k] = f2bf(qd * eg);
            }
            if (tq == 0) ((float*)(smem + HG_DEC))[k] = __expf(last);
            cumG += last;
        }
        __syncthreads();
#pragma unroll
        for (int i = 0; i < 2; ++i) {
            const int ti = w * 2 + i, st = ti >> 2, tt = ti & 3;
            f32x4 sc = {0.f, 0.f, 0.f, 0.f};
            if (tt >= st) {
#pragma unroll
                for (int ks = 0; ks < 4; ++ks) {
                    const s16x8 a = *(const s16x8*)(smem + HG_KM + (st * 16 + (lane & 15)) * HG_QS + (32 * ks + 8 * (lane >> 4)) * 2);
                    const s16x8 bq = *(const s16x8*)(smem + HG_QM + (tt * 16 + (lane & 15)) * HG_QS + (32 * ks + 8 * (lane >> 4)) * 2);
                    sc = __builtin_amdgcn_mfma_f32_16x16x32_bf16(a, bq, sc, 0, 0, 0);
                }
            }
            const int tg = tt * 16 + (lane & 15), sg0 = st * 16 + (lane >> 4) * 4;
            uint2 pk;
            pk.x = pack2(sg0 + 0 <= tg ? sc[0] : 0.f, sg0 + 1 <= tg ? sc[1] : 0.f);
            pk.y = pack2(sg0 + 2 <= tg ? sc[2] : 0.f, sg0 + 3 <= tg ? sc[3] : 0.f);
            *(uint2*)(smem + HG_P + tg * HG_PS + sg0 * 2) = pk;
        }
        f32x4 oacc[3];
#pragma unroll
        for (int i = 0; i < 3; ++i) {
            const int oi = w * 3 + i, tt = oi / 6, vt = oi % 6;
            oacc[i] = (f32x4){0.f, 0.f, 0.f, 0.f};
#pragma unroll
            for (int ks = 0; ks < 4; ++ks) {
                const s16x8 a = *(const s16x8*)(smem + HG_QD + (tt * 16 + (lane & 15)) * HG_QS + (32 * ks + 8 * (lane >> 4)) * 2);
                const s16x8 bs = *(const s16x8*)(smem + HG_ST + (vt * 16 + (lane & 15)) * HG_QS + (32 * ks + 8 * (lane >> 4)) * 2);
                oacc[i] = __builtin_amdgcn_mfma_f32_16x16x32_bf16(a, bs, oacc[i], 0, 0, 0);
            }
        }
        __syncthreads();
#pragma unroll
        for (int i = 0; i < 3; ++i) {
            const int oi = w * 3 + i, tt = oi / 6, vt = oi % 6;
#pragma unroll
            for (int ks = 0; ks < 2; ++ks) {
                const s16x8 a = *(const s16x8*)(smem + HG_P + (tt * 16 + (lane & 15)) * HG_PS + (32 * ks + 8 * (lane >> 4)) * 2);
                const int o = HG_I + (32 * ks + 8 * (lane >> 4) + ((lane & 15) >> 2)) * HG_IS + (vt * 16 + 4 * (lane & 3)) * 2;
                const s16x4 lo = __builtin_amdgcn_ds_read_tr16_b64_v4i16((LAS s16x4*)(smem + o));
                const s16x4 hi = __builtin_amdgcn_ds_read_tr16_b64_v4i16((LAS s16x4*)(smem + o + 4 * HG_IS));
                const s16x8 bi = (s16x8){lo[0], lo[1], lo[2], lo[3], hi[0], hi[1], hi[2], hi[3]};
                oacc[i] = __builtin_amdgcn_mfma_f32_16x16x32_bf16(a, bi, oacc[i], 0, 0, 0);
            }
#pragma unroll
            for (int r = 0; r < 4; ++r)
                ol[(size_t)(tokc + tt * 16 + (lane >> 4) * 4 + r) * 384 + h * 96 + vt * 16 + (lane & 15)] = oacc[i][r];
        }
        {
            const f32x4 dec = *(const f32x4*)(smem + HG_DEC + (w * 16 + (lane >> 4) * 4) * 4);
            s16x8 ak[2];
#pragma unroll
            for (int ks = 0; ks < 2; ++ks) {
                const int o = HG_KD + (32 * ks + 8 * (lane >> 4) + ((lane & 15) >> 2)) * HG_QS + (w * 16 + 4 * (lane & 3)) * 2;
                const s16x4 lo = __builtin_amdgcn_ds_read_tr16_b64_v4i16((LAS s16x4*)(smem + o));
                const s16x4 hi = __builtin_amdgcn_ds_read_tr16_b64_v4i16((LAS s16x4*)(smem + o + 4 * HG_QS));
                ak[ks] = (s16x8){lo[0], lo[1], lo[2], lo[3], hi[0], hi[1], hi[2], hi[3]};
            }
#pragma unroll
            for (int i = 0; i < 6; ++i) {
                S[i] = S[i] * dec;
#pragma unroll
                for (int ks = 0; ks < 2; ++ks) {
                    const int o = HG_I + (32 * ks + 8 * (lane >> 4) + ((lane & 15) >> 2)) * HG_IS + (i * 16 + 4 * (lane & 3)) * 2;
                    const s16x4 lo = __builtin_amdgcn_ds_read_tr16_b64_v4i16((LAS s16x4*)(smem + o));
                    const s16x4 hi = __builtin_amdgcn_ds_read_tr16_b64_v4i16((LAS s16x4*)(smem + o + 4 * HG_IS));
                    const s16x8 bi = (s16x8){lo[0], lo[1], lo[2], lo[3], hi[0], hi[1], hi[2], hi[3]};
                    S[i] = __builtin_amdgcn_mfma_f32_16x16x32_bf16(ak[ks], bi, S[i], 0, 0, 0);
                }
                uint2 pk; pk.x = pack2(S[i][0], S[i][1]); pk.y = pack2(S[i][2], S[i][3]);
                *(uint2*)(smem + HG_ST + (i * 16 + (lane & 15)) * HG_QS + (w * 16 + (lane >> 4) * 4) * 2) = pk;
            }
        }
        __syncthreads();
    }
    {
        const int gi = (b * 4 + h) * 16 + g;
        float* sgp = (float*)(P.ws + WS_SG) + (size_t)gi * 12288;
#pragma unroll
        for (int i = 0; i < 6; ++i)
#pragma unroll
            for (int r = 0; r < 4; ++r) sgp[(w * 16 + (lane >> 4) * 4 + r) * 96 + i * 16 + (lane & 15)] = S[i][r];
        if (tq == 0) ((float*)(P.ws + WS_DG))[gi * 128 + k] = __expf(cumG);
    }
}

__device__ __forceinline__ void hgrn_fix(const Params& P, int l, int b, int h, int g) {
    const int t = tid_opaque(), lane = t & 63, w = t >> 6;
    const u16* qkvp = (const u16*)(P.ws + WS_QKV);
    const u16* qg = (const u16*)(P.ws + WS_QG);
    const float* ol = (const float*)(P.ws + WS_BRAW);
    u16* ob = (u16*)(P.ws + WS_OBUF);
    const int tok0 = b * SEQ + g * 512;
    const int gi0 = (b * 4 + h) * 16;
    float* wgt = (float*)(smem + HG_PART);
    wgt = (float*)(smem + HG_QM);
    if (t == 0) *(volatile int*)(smem + HG_DEC) = 16;
    __syncthreads();
    if (t < 128) {
        float d[16];
#pragma unroll
        for (int j = 0; j < 16; ++j) d[j] = (j < g) ? ((const float*)(P.ws + WS_DG))[(gi0 + j) * 128 + t] : 1.0f;
        float run = 1.0f; int jmin = 16;
#pragma unroll
        for (int j = 15; j >= 0; --j) { wgt[j * 128 + t] = run; if (j < g && run != 0.0f) jmin = j; run *= d[j]; }
        atomicMin((int*)(smem + HG_DEC), jmin);
    }
    __syncthreads();
    const int jfirst = *(volatile int*)(smem + HG_DEC);
    {
        float S[24];
#pragma unroll
        for (int j = 0; j < 24; ++j) S[j] = 0.f;
        const float* sg0 = (const float*)(P.ws + WS_SG) + (size_t)gi0 * 12288;
#pragma unroll 2
        for (int gj = jfirst; gj < g; ++gj) {
#pragma unroll
            for (int j = 0; j < 24; ++j) { const unsigned e = (unsigned)(j * NTHREADS) + (unsigned)t; S[j] += wgt[gj * 128 + e / 96u] * sg0[(unsigned)gj * 12288u + e]; }
        }
#pragma unroll
        for (int j = 0; j < 24; ++j) { const int e = j * NTHREADS + t, kk = e / 96, v = e % 96; *(u16*)(smem + HG_ST + v * HG_QS + kk * 2) = f2bf(S[j]); }
    }
    __syncthreads();
    const float* hg = P.hg + l * 384 + h * 96;
#pragma unroll 1
    for (int i = 0; i < 4; ++i) {
        const int tokt = tok0 + (w * 4 + i) * 16;
        const int tok = tokt + (lane & 15);
        s16x8 bq[4]; f32x4 o4[6]; u32x2 gr[6];
#pragma unroll
        for (int ks = 0; ks < 4; ++ks) bq[ks] = *(const s16x8*)(qg + (size_t)tok * 512 + h * 128 + 32 * ks + 8 * (lane >> 4));
#pragma unroll
        for (int vt = 0; vt < 6; ++vt) {
            const int vc = vt * 16 + (lane >> 4) * 4;
            o4[vt] = *(const f32x4*)(ol + (size_t)tok * 384 + h * 96 + vc);
            gr[vt] = *(const u32x2*)(qkvp + (size_t)tok * INW + C_BG + h * 96 + vc);
        }
        f32x4 acc[6];
#pragma unroll
        for (int vt = 0; vt < 6; ++vt) acc[vt] = (f32x4){0.f, 0.f, 0.f, 0.f};
#pragma unroll
        for (int ks = 0; ks < 4; ++ks) {
#pragma unroll
            for (int vt = 0; vt < 6; ++vt) {
                const s16x8 a = *(const s16x8*)(smem + HG_ST + (vt * 16 + (lane & 15)) * HG_QS + (32 * ks + 8 * (lane >> 4)) * 2);
                acc[vt] = __builtin_amdgcn_mfma_f32_16x16x32_bf16(a, bq[ks], acc[vt], 0, 0, 0);
            }
            __builtin_amdgcn_sched_barrier(0);
        }
        float ss = 0.f;
#pragma unroll
        for (int vt = 0; vt < 6; ++vt) {
            acc[vt] = acc[vt] + o4[vt];
            ss += acc[vt][0] * acc[vt][0] + acc[vt][1] * acc[vt][1] + acc[vt][2] * acc[vt][2] + acc[vt][3] * acc[vt][3];
        }
        ss += xshfl<16>(ss); ss += xshfl<32>(ss);
        const float rs = rsqrtf(ss * (1.0f / 96.0f) + 1e-6f);
#pragma unroll
        for (int vt = 0; vt < 6; ++vt) {
            const int vc = vt * 16 + (lane >> 4) * 4;
            const f32x4 hv = *(const f32x4*)(hg + vc);
            const float g0 = __uint_as_float(gr[vt][0] << 16), g1 = __uint_as_float(gr[vt][0] & 0xffff0000u), g2 = __uint_as_float(gr[vt][1] << 16), g3 = __uint_as_float(gr[vt][1] & 0xffff0000u);
            u32x2 pk;
            pk[0] = pack2(acc[vt][0] * rs * hv[0] * (g0 * fsigmoid(g0)), acc[vt][1] * rs * hv[1] * (g1 * fsigmoid(g1)));
            pk[1] = pack2(acc[vt][2] * rs * hv[2] * (g2 * fsigmoid(g2)), acc[vt][3] * rs * hv[3] * (g3 * fsigmoid(g3)));
            *(u32x2*)(ob + (size_t)tok * 1024 + 384 + h * 96 + vc) = pk;
        }
    }
    __syncthreads();
}

constexpr int RT_ASTR = 144, RT_BSTR = 576, RT_A = 128 * RT_ASTR, RT_B = 64 * RT_BSTR, RT_STAGE = RT_A + RT_B, RT_LGS = 260;
constexpr int RT_ASG = LDS_HDR + 128 * RT_LGS * 4;
static_assert(LDS_HDR + 2 * RT_STAGE <= LDS_BYTES && RT_ASG + 12288 + 2048 + 512 <= LDS_BYTES, "lds router");
__device__ __forceinline__ void router_tile(const u16* A, const float* W) {
    const int t = tid_opaque(), lane = t & 63, w = t >> 6, wr = w >> 2, wc = w & 3;
    const int nq = t & 63, kb = t >> 6;
    u32x4 ra[2]; f32x4 rb[8];
    auto gload = [&](int kt) __attribute__((always_inline)) {
#pragma unroll
        for (int i = 0; i < 2; ++i) ra[i] = *(const u32x4*)(A + (unsigned)((t >> 3) + 64 * i) * 1024u + (t & 7) * 8 + kt * 64);
#pragma unroll
        for (int i = 0; i < 8; ++i) rb[i] = *(const f32x4*)(W + (unsigned)(kt * 64 + kb + 8 * i) * 256u + nq * 4);
    };
    auto lwrite = [&](int buf) __attribute__((always_inline)) {
        const int ab = LDS_HDR + buf * RT_STAGE, bb = ab + RT_A;
#pragma unroll
        for (int i = 0; i < 2; ++i) *(u32x4*)(smem + ab + ((t >> 3) + 64 * i) * RT_ASTR + (t & 7) * 16) = ra[i];
#pragma unroll
        for (int i = 0; i < 8; ++i) { u32x2 p; p[0] = pack2(rb[i][0], rb[i][1]); p[1] = pack2(rb[i][2], rb[i][3]); *(u32x2*)(smem + bb + (kb + 8 * i) * RT_BSTR + nq * 8) = p; }
    };
    f32x16 acc[2][2];
#pragma unroll
    for (int m = 0; m < 2; ++m)
#pragma unroll
        for (int n = 0; n < 2; ++n)
#pragma unroll
            for (int r = 0; r < 16; ++r) acc[m][n][r] = 0.f;
    const int a_rd = (wr * 64 + (lane & 31)) * RT_ASTR + (lane >> 5) * 16;
    const int b_rd = ((lane >> 5) * 8 + ((lane & 15) >> 2)) * RT_BSTR + (wc * 64 + 16 * ((lane >> 4) & 1) + 4 * (lane & 3)) * 2;
    gload(0);
    lwrite(0);
    __syncthreads();
    for (int s = 0; s < 16; ++s) {
        const int buf = s & 1;
        if (s + 1 < 16) gload(s + 1);
        const int ab = LDS_HDR + buf * RT_STAGE, bb = ab + RT_A;
#pragma unroll
        for (int kk = 0; kk < 4; ++kk) {
            s16x8 af[2], bf[2];
#pragma unroll
            for (int m = 0; m < 2; ++m) af[m] = *(const s16x8*)(smem + ab + a_rd + m * 32 * RT_ASTR + kk * 32);
#pragma unroll
            for (int n = 0; n < 2; ++n) {
                const int o = bb + b_rd + kk * 16 * RT_BSTR + n * 64;
                const s16x4 lo = __builtin_amdgcn_ds_read_tr16_b64_v4i16((LAS s16x4*)(smem + o));
                const s16x4 hi = __builtin_amdgcn_ds_read_tr16_b64_v4i16((LAS s16x4*)(smem + o + 4 * RT_BSTR));
                bf[n] = (s16x8){lo[0], lo[1], lo[2], lo[3], hi[0], hi[1], hi[2], hi[3]};
            }
#pragma unroll
            for (int m = 0; m < 2; ++m)
#pragma unroll
                for (int n = 0; n < 2; ++n) acc[m][n] = __builtin_amdgcn_mfma_f32_32x32x16_bf16(af[m], bf[n], acc[m][n], 0, 0, 0);
        }
        if (s + 1 < 16) lwrite(buf ^ 1);
        __syncthreads();
    }
    float* lg = (float*)(smem + LDS_HDR);
#pragma unroll
    for (int m = 0; m < 2; ++m)
#pragma unroll
        for (int n = 0; n < 2; ++n)
#pragma unroll
            for (int r = 0; r < 16; ++r)
                lg[(wr * 64 + m * 32 + (r & 3) + 8 * (r >> 2) + 4 * (lane >> 5)) * RT_LGS + wc * 64 + n * 32 + (lane & 31)] = acc[m][n][r];
    __syncthreads();
}

struct F8 { f32x4 lo, hi; };
__device__ __forceinline__ F8 bf8_to_f(const u32x4 r) {
    F8 o;
    o.lo = (f32x4){__uint_as_float(r[0] << 16), __uint_as_float(r[0] & 0xffff0000u), __uint_as_float(r[1] << 16), __uint_as_float(r[1] & 0xffff0000u)};
    o.hi = (f32x4){__uint_as_float(r[2] << 16), __uint_as_float(r[2] & 0xffff0000u), __uint_as_float(r[3] << 16), __uint_as_float(r[3] & 0xffff0000u)};
    return o;
}
template <int NT, class AF, class BF, class OF>
__device__ __forceinline__ void ln_tokens(AF arow, BF bfun, const float* g, const float* be, OF orow, int lane) {
    F8 v[NT][2]; float s[NT];
#pragma unroll
    for (int q = 0; q < NT; ++q) {
        const u16* a = arow(q);
        s[q] = 0.f;
#pragma unroll
        for (int j = 0; j < 2; ++j) {
            const int c = j * 512 + lane * 8;
            const F8 av = bf8_to_f(*(const u32x4*)(a + c));
            const F8 bv = bfun(q, c);
            v[q][j].lo = av.lo * ALPHA + bv.lo; v[q][j].hi = av.hi * ALPHA + bv.hi;
            s[q] += (v[q][j].lo[0] + v[q][j].lo[1]) + (v[q][j].lo[2] + v[q][j].lo[3]) + (v[q][j].hi[0] + v[q][j].hi[1]) + (v[q][j].hi[2] + v[q][j].hi[3]);
        }
    }
#define LN_RED(X) _Pragma("unroll") for (int q = 0; q < NT; ++q) X[q] += xshfl<1>(X[q]); _Pragma("unroll") for (int q = 0; q < NT; ++q) X[q] += xshfl<2>(X[q]); \
    _Pragma("unroll") for (int q = 0; q < NT; ++q) X[q] += dpp_f<0x141>(X[q]); _Pragma("unroll") for (int q = 0; q < NT; ++q) X[q] += dpp_f<0x140>(X[q]); \
    _Pragma("unroll") for (int q = 0; q < NT; ++q) X[q] += xshfl<16>(X[q]); _Pragma("unroll") for (int q = 0; q < NT; ++q) X[q] += xshfl<32>(X[q]);
    LN_RED(s)
    float qq[NT];
#pragma unroll
    for (int q = 0; q < NT; ++q) {
        const float mu = s[q] * (1.0f / 1024.0f);
        qq[q] = 0.f;
#pragma unroll
        for (int j = 0; j < 2; ++j) {
            v[q][j].lo = v[q][j].lo - mu; v[q][j].hi = v[q][j].hi - mu;
            const f32x4 a2 = v[q][j].lo * v[q][j].lo + v[q][j].hi * v[q][j].hi;
            qq[q] += (a2[0] + a2[1]) + (a2[2] + a2[3]);
        }
    }
    LN_RED(qq)
#undef LN_RED
#pragma unroll
    for (int j = 0; j < 2; ++j) {
        const int c = j * 512 + lane * 8;
        const f32x4 g0 = *(const f32x4*)(g + c), g1 = *(const f32x4*)(g + c + 4), b0 = *(const f32x4*)(be + c), b1 = *(const f32x4*)(be + c + 4);
#pragma unroll
        for (int q = 0; q < NT; ++q) {
            const float rs = rsqrtf(qq[q] * (1.0f / 1024.0f) + LN_EPS);
            orow(q, c, v[q][j].lo * rs * g0 + b0, v[q][j].hi * rs * g1 + b1);
        }
    }
}

__device__ __forceinline__ Params load_params() {
#if defined(__HIP_DEVICE_COMPILE__)
    typedef __attribute__((address_space(4))) const Params CP;
    CP* p = (CP*)__builtin_amdgcn_kernarg_segment_ptr();
    asm volatile("" : "+s"(p));
    return *p;
#else
    return Params{};
#endif
}
__device__ __forceinline__ int opq_s(int v) { asm volatile("" : "+s"(v)); return v; }
#define LOADP const Params P = load_params(); const int bid = opq_s((int)blockIdx.x), G = opq_s((int)gridDim.x); (void)bid; (void)G
#define GRID_SYNC() do { XcdBarrier b_; b_.bar = (unsigned*)(load_params().ws + WS_CTL); b_.x = xb_xcc_id(); b_.st = (volatile LAS unsigned*)smem; xcd_barrier(b_); } while (0)
__global__ void __launch_bounds__(NTHREADS, 2) fwd_kernel(Params Pk_) {
    if (threadIdx.x < 4) ((volatile unsigned*)smem)[threadIdx.x] = 0u;
    __syncthreads();
    { LOADP; (void)xcd_barrier_post((unsigned*)(P.ws + WS_CTL), (volatile LAS unsigned*)smem); }

#define qkv ((u16*)(P.ws + WS_QKV))
#define obuf ((u16*)(P.ws + WS_OBUF))
#define mix ((float*)(P.ws + WS_MIX))
#define h1 ((float*)(P.ws + WS_H1))
#define hcur ((float*)(P.ws + WS_HCUR))
#define logits ((float*)(P.ws + WS_LOGITS))
#define gatebuf ((float*)(P.ws + WS_GATE))
#define list ((int*)(P.ws + WS_LIST))
#define hbuf ((u16*)(P.ws + WS_HBUF))
#define slots ((u16*)(P.ws + WS_SLOTS))
#define hb ((u16*)(P.ws + WS_HB))
#define h1b ((u16*)(P.ws + WS_H1B))
#define h1l ((u16*)(P.ws + WS_H1L))
#define hin ((l == 0) ? P.x : (const float*)hcur)
#define count ((int*)(P.ws + WS_CTL + CTL_COUNT_OFF) + l * 256)
    int* prefix = (int*)(smem + LDS_PREFIX);

    { LOADP; const int t = tid_opaque();
    for (size_t i = ((size_t)bid * NTHREADS + t) * 4; i < (size_t)T * D; i += (size_t)G * NTHREADS * 4) {
        const f32x4 v = *(const f32x4*)(P.x + i);
        uint2 p; p.x = pack2(v[0], v[1]); p.y = pack2(v[2], v[3]);
        *(uint2*)(hb + i) = p;
    } }
    {
        LOADP;
        constexpr int NBIN = 16 * 27, NBOUT = 16 * 8;
        for (int u = bid; u < 2 * (NBIN + NBOUT); u += G) {
            const int ll = u / (NBIN + NBOUT), v = u % (NBIN + NBOUT);
            if (v < NBIN) conv_block(P.w_in + (size_t)ll * D * INW, INW, (v / 27) * 64, (v % 27) * 128, (u16*)(P.ws + WS_WIN) + (size_t)ll * 3584 * 1024, [](int n) { return (size_t)n * 1024; });
            else { const int v2 = v - NBIN; conv_block(P.w_out + (size_t)ll * 1024 * 1024, 1024, (v2 / 8) * 64, (v2 % 8) * 128, (u16*)(P.ws + WS_WOUT) + (size_t)ll * 1024 * 1024, [](int n) { return (size_t)n * 1024; }); }
        }
    }

    auto layer_body = [&](const int l) __attribute__((always_inline)) {
        if (l == 0) GRID_SYNC();
        PH(0)
        {
            LOADP;
#ifndef CONV_SIDE_WGS
#define CONV_SIDE_WGS 1
#endif
            const bool split = CONV_SIDE_WGS && (G == 256);
            const int jx = bid >> 3, qx = bid & 7;
#ifndef NCJ
#define NCJ 13
#endif
            const bool is_conv = split && (jx >= 32 - NCJ);
            const int conv_rank = split ? ((jx - (32 - NCJ)) * 8 + qx) : bid, conv_n = split ? NCJ * 8 : G;
            const int cmp_rank = bid, cmp_n = split ? (32 - NCJ) * 8 : G;
            unsigned* cvctr = (unsigned*)(P.ws + WS_CTL + CTL_COUNT_OFF + 8192) + l * 64;
            auto cvdesc = [&](int u) {
                const int e = u / 48, v = u % 48;
                CvDesc d;
                if (v < 32) {
                    const int isu = v >> 4, kbk = v & 15;
                    const float* srcw = (e < 256) ? ((isu ? P.wu : P.wg) + ((size_t)l * NE + e) * D * FF) : ((isu ? P.su : P.sg) + (size_t)l * D * FF);
                    d.src = srcw + (size_t)kbk * 64 * FF; d.ld = FF; d.dst = (u16*)((unsigned char*)(P.ws + WS_WGU) + (size_t)e * 2 * 256 * 1024 + kbk * 64); d.rs_hi = 256; d.radd = isu * 128; d.dk = 1024; d.f8 = true;
                } else {
                    const int v2 = v - 32, kbk = v2 & 3, nb = v2 >> 2;
                    const float* srcw = (e < 256) ? (P.wd + ((size_t)l * NE + e) * FF * D) : (P.sd + (size_t)l * FF * D);
                    d.src = srcw + (size_t)kbk * 64 * D + nb * 256; d.ld = D; d.dst = (u16*)((unsigned char*)(P.ws + WS_WD) + (size_t)e * 1024 * 256 + (size_t)nb * 256 * 256 + kbk * 64); d.rs_hi = 128; d.radd = 0; d.dk = 256; d.f8 = true;
                }
                return d;
            };
            if (is_conv) conv_stream_dyn(257 * 48, cvctr, cvdesc);
            if (!is_conv) {
            eg::DenseSched S; S.A = (const char*)hb; S.Bt = (const char*)(P.ws + WS_WIN) + (size_t)l * 3584 * 1024 * 2; S.K = 1024; S.nM = 128; S.nN = 14; S.nwg = 128 * 14; S.G = cmp_n; S.c = cmp_rank;
            u16* q = qkv;
            eg::gemm_stream<1, false, 0>(2048, 2048, S, [&](const f32x4 (&acc)[2][2][4][2], const eg::DenseUnit& u, int wr, int wc, int fr, int fq, const LAS unsigned*) {
#pragma unroll
                for (int ai = 0; ai < 2; ++ai)
#pragma unroll
                    for (int m = 0; m < 4; ++m) {
                        u16* rowp = q + (size_t)(u.pm * 256 + ai * 128 + wr * 64 + m * 16 + fr) * INW + u.pn * 256 + wc * 32 + 8 * fq;
#pragma unroll
                        for (int bj = 0; bj < 2; ++bj) {
                            if (u.pn * 256 + bj * 128 < INW) {
                                const f32x4 v0 = acc[ai][bj][m][0], v1 = acc[ai][bj][m][1];
                                u32x4 p; p[0] = pack2(v0[0], v0[1]); p[1] = pack2(v0[2], v0[3]); p[2] = pack2(v1[0], v1[1]); p[3] = pack2(v1[2], v1[3]);
                                *(u32x4*)(rowp + bj * 128) = p;
                            }
                        }
                    }
            });
            conv_stream_dyn(257 * 48, cvctr, cvdesc);
            }
        }
        GRID_SYNC();
        PH(1)
        {
            LOADP;
            for (int r2 = 0; r2 < (((REPMASK >> 11) & 1) ? 2 : 1); ++r2) for (int u = bid; u < 256; u += G) hgrn_group(P, l, u >> 6, (u >> 4) & 3, u & 15);
            for (int r2 = 0; r2 < (((REPMASK >> 12) & 1) ? 2 : 1); ++r2) attn_phase<0>(P, l, bid, G);
        }
        GRID_SYNC();
        PH(2)
        {
            LOADP;
            for (int r2 = 0; r2 < (((REPMASK >> 13) & 1) ? 2 : 1); ++r2) for (int u = bid; u < 256; u += G) hgrn_fix(P, l, u >> 6, (u >> 4) & 3, u & 15);
            for (int r2 = 0; r2 < (((REPMASK >> 14) & 1) ? 2 : 1); ++r2) attn_phase<1>(P, l, bid, G);
        }
        GRID_SYNC();
        PH(3)
        {
            LOADP;
            eg::DenseSched S; S.A = (const char*)obuf; S.Bt = (const char*)(P.ws + WS_WOUT) + (size_t)l * 1024 * 1024 * 2; S.K = 1024; S.nM = 128; S.nN = 4; S.nwg = 128 * 4; S.G = G; S.c = bid;
            u16* mx = (u16*)(P.ws + WS_MIX);
            eg::gemm_stream<1, false, 0>(2048, 2048, S, [&](const f32x4 (&acc)[2][2][4][2], const eg::DenseUnit& u, int wr, int wc, int fr, int fq, const LAS unsigned*) {
#pragma unroll
                for (int ai = 0; ai < 2; ++ai)
#pragma unroll
                    for (int m = 0; m < 4; ++m) {
                        u16* rowp = mx + (size_t)(u.pm * 256 + ai * 128 + wr * 64 + m * 16 + fr) * 1024 + u.pn * 256 + wc * 32 + 8 * fq;
#pragma unroll
                        for (int bj = 0; bj < 2; ++bj) {
                            const f32x4 v0 = acc[ai][bj][m][0], v1 = acc[ai][bj][m][1];
                            u32x4 p; p[0] = pack2(v0[0], v0[1]); p[1] = pack2(v0[2], v0[3]); p[2] = pack2(v1[0], v1[1]); p[3] = pack2(v1[2], v1[3]);
                            *(u32x4*)(rowp + bj * 128) = p;
                        }
                    }
            });
        }
        GRID_SYNC();
        PH(4)
        {
            LOADP;
            const int t = tid_opaque(), lane = t & 63, wave = t >> 6;
            const float* rb = P.rb + l * 256;
            const f32x4 bias4 = *(const f32x4*)(rb + lane * 4);
            int* asg_e = (int*)(smem + RT_ASG); int* asg_r = asg_e + 1024; float* asg_g = (float*)(asg_r + 1024);
            int* lhist = (int*)(asg_g + 1024); int* gbase = lhist + 256;
            for (int blk = bid; blk < T / 128; blk += G) {
            for (int r2 = 0; r2 < (((REPMASK >> 15) & 1) ? 2 : 1); ++r2)
            for (int i = 0; i < 16; i += 4) {
                const int tokb = blk * 128 + wave * 16 + i;
                const u16* mixp = (const u16*)(P.ws + WS_MIX);
                ln_tokens<4>([&](int q) { return (const u16*)hb + (size_t)(tokb + q) * 1024; },
                             [&](int q, int c) { return bf8_to_f(*(const u32x4*)(mixp + (size_t)(tokb + q) * 1024 + c)); },
                             P.ln1g + l * 1024, P.ln1b + l * 1024,
                             [&](int q, int c, const f32x4 y0, const f32x4 y1) {
                                 u32x4 p; p[0] = pack2(y0[0], y0[1]); p[1] = pack2(y0[2], y0[3]); p[2] = pack2(y1[0], y1[1]); p[3] = pack2(y1[2], y1[3]);
                                 *(u32x4*)(h1b + (size_t)(tokb + q) * 1024 + c) = p;
                                 u32x2 p8;
                                 p8[0] = (unsigned)__builtin_amdgcn_cvt_pk_fp8_f32(y0[2], y0[3], __builtin_amdgcn_cvt_pk_fp8_f32(y0[0], y0[1], 0, false), true);
                                 p8[1] = (unsigned)__builtin_amdgcn_cvt_pk_fp8_f32(y1[2], y1[3], __builtin_amdgcn_cvt_pk_fp8_f32(y1[0], y1[1], 0, false), true);
                                 *(u32x2*)((unsigned char*)(P.ws + WS_H1L) + (size_t)(tokb + q) * 1024 + c) = p8; }, lane);
            }
            asm volatile("s_waitcnt vmcnt(0)" ::: "memory");
            __syncthreads();
            __builtin_amdgcn_fence(__ATOMIC_ACQUIRE, "agent");
            for (int r2 = 0; r2 < (((REPMASK >> 16) & 1) ? 2 : 1); ++r2) router_tile(h1b + (size_t)blk * 128 * 1024, P.rw + (size_t)l * 1024 * 256);
            if (t < 256) lhist[t] = 0;
            __syncthreads();
            {
                const int hh = lane >> 5, l32 = lane & 31, gq = l32 >> 2;
                const f32x4 bA = *(const f32x4*)(rb + l32 * 8), bB = *(const f32x4*)(rb + l32 * 8 + 4);
                const float bias8[8] = {bA[0], bA[1], bA[2], bA[3], bB[0], bB[1], bB[2], bB[3]};
                const unsigned idxc = 255u - (unsigned)(l32 * 8);
                float* tsc = (float*)(gbase + 256);
                if (lane < 16) {
                    const int tok = blk * 128 + wave * 16 + lane;
                    ((unsigned*)(P.ws + WS_RDST))[(size_t)256 * T + tok] = ((unsigned)tok * 9u + 8u) * 1024u;
                    ((float*)(P.ws + WS_RGATE))[(size_t)256 * T + tok] = 1.0f;
                }
#pragma unroll 1
                for (int pp = 0; pp < 8; pp += 2) {
                    unsigned k[2][8], ks[2][8], rr[2], cnt[2];
#pragma unroll
                    for (int q = 0; q < 2; ++q) {
                        const int row = wave * 16 + (pp + q) * 2 + hh;
                        const float* lgp = (const float*)(smem + LDS_HDR) + row * RT_LGS + l32 * 8;
                        const f32x4 l0 = *(const f32x4*)lgp, l1 = *(const f32x4*)(lgp + 4);
                        float c[8];
#pragma unroll
                        for (int i = 0; i < 4; ++i) { c[i] = fsigmoid(l0[i]) + bias8[i]; c[4 + i] = fsigmoid(l1[i]) + bias8[4 + i]; }
                        float a1 = rmax(c[0], c[1]), a2 = rmin(c[0], c[1]);
#pragma unroll
                        for (int i = 2; i < 8; i += 2) { const float b1 = rmax(c[i], c[i + 1]), b2 = rmin(c[i], c[i + 1]); const float n1 = rmax(a1, b1); a2 = rmax(rmin(a1, b1), rmax(a2, b2)); a1 = n1; }
                        { const float b1 = dpp_f<0xB1>(a1), b2 = dpp_f<0xB1>(a2); const float n1 = rmax(a1, b1); a2 = rmax(rmin(a1, b1), rmax(a2, b2)); a1 = n1; }
                        { const float b1 = dpp_f<0x4E>(a1), b2 = dpp_f<0x4E>(a2); const float n1 = rmax(a1, b1); a2 = rmax(rmin(a1, b1), rmax(a2, b2)); a1 = n1; }
                        const unsigned gkey = (__float_as_uint(rmax(a1 + a2, 0.f)) & ~7u) | (unsigned)(7 - gq);
                        const unsigned xk = (unsigned)xshfl_i<16>((int)gkey);
                        int rank = (xk > gkey) ? 1 : 0;
                        rank += (dpp_u<0x124>(gkey) > gkey) ? 1 : 0; rank += (dpp_u<0x128>(gkey) > gkey) ? 1 : 0; rank += (dpp_u<0x12C>(gkey) > gkey) ? 1 : 0;
                        rank += (dpp_u<0x124>(xk) > gkey) ? 1 : 0; rank += (dpp_u<0x128>(xk) > gkey) ? 1 : 0; rank += (dpp_u<0x12C>(xk) > gkey) ? 1 : 0;
                        const unsigned km = rank < 4 ? 0xFFFFFF00u : 0u;
#pragma unroll
                        for (int i = 0; i < 8; ++i) k[q][i] = (__float_as_uint(rmax(c[i], 0.f)) & km) | (idxc - (unsigned)i);
#define RT_CX(a, b) { const unsigned hi_ = k[q][a] > k[q][b] ? k[q][a] : k[q][b], lo_ = k[q][a] > k[q][b] ? k[q][b] : k[q][a]; k[q][a] = hi_; k[q][b] = lo_; }
                        RT_CX(0, 1) RT_CX(2, 3) RT_CX(4, 5) RT_CX(6, 7) RT_CX(0, 2) RT_CX(1, 3) RT_CX(4, 6) RT_CX(5, 7) RT_CX(1, 2) RT_CX(5, 6)
                        RT_CX(0, 4) RT_CX(1, 5) RT_CX(2, 6) RT_CX(3, 7) RT_CX(2, 4) RT_CX(3, 5) RT_CX(1, 2) RT_CX(3, 4) RT_CX(5, 6)
#undef RT_CX
#pragma unroll
                        for (int i = 0; i < 8; ++i) ks[q][i] = k[q][i];
                        rr[q] = 0u; cnt[q] = 0u;
                    }
#pragma unroll 1
                    for (int rd = 0; rd < 8; ++rd) {
#pragma unroll
                        for (int q = 0; q < 2; ++q) {
                            unsigned wm = k[q][0];
                            { const unsigned o = dpp_u<0xB1>(wm); wm = o > wm ? o : wm; } { const unsigned o = dpp_u<0x4E>(wm); wm = o > wm ? o : wm; }
                            { const unsigned o = dpp_u<0x141>(wm); wm = o > wm ? o : wm; } { const unsigned o = dpp_u<0x140>(wm); wm = o > wm ? o : wm; }
                            { const unsigned o = (unsigned)xshfl_i<16>((int)wm); wm = o > wm ? o : wm; }
                            const bool own = (k[q][0] == wm);
#pragma unroll
                            for (int i = 0; i < 7; ++i) k[q][i] = own ? k[q][i + 1] : k[q][i];
                            k[q][7] = own ? 0u : k[q][7];
                            rr[q] = own ? ((rr[q] << 3) | (unsigned)rd) : rr[q];
                            cnt[q] += own ? 1u : 0u;
                        }
                    }
#pragma unroll
                    for (int q = 0; q < 2; ++q) {
                        const int row = wave * 16 + (pp + q) * 2 + hh;
                        float psum = 0.f;
#pragma unroll
                        for (int j = 0; j < 8; ++j) {
                            if (__builtin_amdgcn_ballot_w64((int)cnt[q] > j) == 0ull) break;
                            if ((int)cnt[q] > j) {
                                const unsigned key = ks[q][j];
                                const int e = 255 - (int)(key & 255u);
                                const float sv = __uint_as_float(key & 0xFFFFFF00u) - rb[e];
                                const int slot = (int)((rr[q] >> (3u * (cnt[q] - 1u - (unsigned)j))) & 7u);
                                const int a = row * 8 + slot;
                                asg_e[a] = e; asg_r[a] = atomicAdd(&lhist[e], 1); asg_g[a] = sv;
                                psum += sv;
                            }
                        }
                        psum += dpp_f<0xB1>(psum); psum += dpp_f<0x4E>(psum); psum += dpp_f<0x141>(psum); psum += dpp_f<0x140>(psum); psum += xshfl<16>(psum);
                        if (l32 == 0) tsc[row] = 2.5f / psum;
                    }
                }
            }
            __syncthreads();
            { const int t2 = tid_opaque(); if (t2 < 256) { const int c = lhist[t2]; gbase[t2] = c ? atomicAdd(&count[t2], c) : 0; } }
            __syncthreads();
            for (int a = t; a < 1024; a += NTHREADS) {
                const int k = a & 7, tok = blk * 128 + (a >> 3);
                if (tok < T) {
                    const int e = asg_e[a]; const int pos = gbase[e] + asg_r[a];
                    list[(size_t)e * T + pos] = tok * 8 + k;
                    ((unsigned*)(P.ws + WS_RDST))[(size_t)e * T + pos] = ((unsigned)tok * 9u + (unsigned)k) * 1024u;
                    ((float*)(P.ws + WS_RGATE))[(size_t)e * T + pos] = asg_g[a] * ((const float*)(gbase + 256))[a >> 3];
                }
            }
            __syncthreads();
            }
        }
        GRID_SYNC();
        {
            LOADP;
            const int t = tid_opaque();
            int* tmp = (int*)(smem + LDS_HDR);
            if (t < NE) tmp[t] = (count[t] + 255) >> 8;
            __syncthreads();
            if (t < 64) {
                const int a0 = tmp[t * 4], a1 = tmp[t * 4 + 1], a2 = tmp[t * 4 + 2], a3 = tmp[t * 4 + 3];
                const int s = a0 + a1 + a2 + a3;
                int inc = s;
#pragma unroll
                for (int o = 1; o < 64; o <<= 1) { const int v = __builtin_amdgcn_ds_bpermute(((t & 63) - o) << 2, inc); if ((t & 63) >= o) inc += v; }
                const int ex = inc - s;
                prefix[t * 4] = ex; prefix[t * 4 + 1] = ex + a0; prefix[t * 4 + 2] = ex + a0 + a1; prefix[t * 4 + 3] = ex + a0 + a1 + a2;
                if (t == 63) prefix[NE] = inc;
            }
            __syncthreads();
        }
        const int ntiles = prefix[NE];
        {
            LOADP;
            const int t = tid_opaque();
            for (int tile = t; tile < ntiles; tile += NTHREADS) {
                int jj = 0;
#pragma unroll 1
                for (int s = 128; s > 0; s >>= 1) if (prefix[jj + s] <= tile) jj += s;
                const int mt = tile - prefix[jj]; int cn = count[jj] - mt * 256; cn = cn > 256 ? 256 : cn;
                ((unsigned*)(smem + eg::EG_TAB))[tile] = (unsigned)jj | ((unsigned)mt << 9) | ((unsigned)cn << 16);
            }
            for (int e = bid; e < NE; e += G) {
                const int ce = count[e];
                for (int r = ce + t; r < ((ce + 255) & ~255); r += NTHREADS) {
                    ((unsigned*)(P.ws + WS_RDST))[(size_t)e * T + r] = (unsigned)T * 9u * 1024u + (unsigned)(r & 255) * 1024u;
                    ((float*)(P.ws + WS_RGATE))[(size_t)e * T + r] = 0.f;
                }
            }
            __syncthreads();
        }
        PH(7)
        {
            LOADP;
            eg::MoeSched<2, true, false> S; S.abytes = 0; S.A = (const char*)(P.ws + WS_H1L); S.W = (const char*)(P.ws + WS_WGU);   S.lst = list; S.cnts = count; S.gcum = prefix; S.rdst = nullptr; S.ntiles = ntiles; S.G = G; S.c = bid;
            S.wstride_e = (size_t)2 * 256 * 1024; S.wstride_sub = (size_t)256 * 1024;
            u16* hbp = hbuf;
            eg::gemm_stream<1, true, 8>(1024, 1024, S, [&](const f32x4 (&acc)[2][2][4][2], const eg::MoeUnit& u, int wr, int wc, int fr, int fq, const LAS unsigned*) {
#pragma unroll
                for (int ai = 0; ai < 2; ++ai)
#pragma unroll
                    for (int m = 0; m < 4; ++m) {
                        unsigned char* rowp = (unsigned char*)hbp + ((size_t)u.tile * 256 + ai * 128 + wr * 64 + m * 16 + fr) * 256 + u.sub * 128 + wc * 32 + 8 * fq;
                        u32x2 p;
#pragma unroll
                        for (int n = 0; n < 2; ++n) {
                            const f32x4 Gv = acc[ai][0][m][n], Uv = acc[ai][1][m][n];
                            f32x2 h2[2];
#pragma unroll
                            for (int hh = 0; hh < 2; ++hh) {
                                const f32x2 G2 = {Gv[2 * hh], Gv[2 * hh + 1]}, U2 = {Uv[2 * hh], Uv[2 * hh + 1]};
                                const f32x2 t2 = G2 * (-1.44269504088896341f / 64.0f);
                                const f32x2 d2 = (f32x2){__builtin_amdgcn_exp2f(t2[0]), __builtin_amdgcn_exp2f(t2[1])} + 1.0f;
                                const f32x2 r2 = {__builtin_amdgcn_rcpf(d2[0]), __builtin_amdgcn_rcpf(d2[1])};
                                h2[hh] = (G2 * (1.0f / 1024.0f)) * U2 * r2;
                            }
                            p[n] = (unsigned)__builtin_amdgcn_cvt_pk_fp8_f32(h2[1][0], h2[1][1], __builtin_amdgcn_cvt_pk_fp8_f32(h2[0][0], h2[0][1], 0, false), true);
                        }
                        *(u32x2*)rowp = p;
                    }
            });
        }
        GRID_SYNC();
        PH(8)
        {
            LOADP;
            eg::MoeSched<4, false, true> S; S.A = (const char*)hbuf; S.W = (const char*)(P.ws + WS_WD); S.abytes = 256 * 256; S.lst = list; S.cnts = count; S.gcum = prefix; S.rdst = (const unsigned*)(P.ws + WS_RDST);
            S.ntiles = ntiles; S.G = G; S.c = bid; S.wstride_e = (size_t)1024 * 256; S.wstride_sub = (size_t)256 * 256;
            u16* sl = slots;
            eg::gemm_stream<2, true, 8>(256, 256, S, [&](const f32x4 (&acc)[2][2][4][2], const eg::MoeUnit& u, int wr, int wc, int fr, int fq, const LAS unsigned* ri) {
                LAS unsigned char* eb = (LAS unsigned char*)(smem + eg::EG_EPB);
                const int waddr = (wr * 16 + fr) * 256 + (((wc * 4 + fq) ^ fr) << 4);
                const int rrow = (wr * 4 + wc) * 4 + fq;
                const int raddr = rrow * 256 + ((fr ^ (rrow & 15)) << 4);
                const int rurow = (rrow >> 4) * 64 + (rrow & 15);
                unsigned char* sbase = (unsigned char*)sl + (unsigned)(u.sub * 256 + fr * 16);
#pragma unroll
                for (int ai = 0; ai < 2; ++ai)
#pragma unroll
                    for (int m = 0; m < 4; ++m) {
                        const int row = ai * 128 + wr * 64 + m * 16 + fr;
                        const float gt = __uint_as_float(ri[256 + row]);
                        const float g16 = gt * (16.0f / 256.0f);
                        u32x4 p;
#pragma unroll
                        for (int bj = 0; bj < 2; ++bj) {
                            const f32x4 v0 = acc[ai][bj][m][0] * g16, v1 = acc[ai][bj][m][1] * g16;
                            p[2 * bj] = (unsigned)__builtin_amdgcn_cvt_pk_fp8_f32(v0[2], v0[3], __builtin_amdgcn_cvt_pk_fp8_f32(v0[0], v0[1], 0, false), true);
                            p[2 * bj + 1] = (unsigned)__builtin_amdgcn_cvt_pk_fp8_f32(v1[2], v1[3], __builtin_amdgcn_cvt_pk_fp8_f32(v1[0], v1[1], 0, false), true);
                        }
                        const int bo = (m & 1) * 8192;
                        *(LAS u32x4*)(eb + bo + waddr) = p;
                        asm volatile("s_waitcnt lgkmcnt(0)" ::: "memory");
                        __builtin_amdgcn_s_barrier();
                        const u32x4 v = *(const LAS u32x4*)(eb + bo + raddr);
                        const unsigned dst = ri[ai * 128 + m * 16 + rurow];
                        *(u32x4*)(sbase + dst) = v;
                    }
            });
        }
        GRID_SYNC();
        PH(9)
        {
            LOADP;
            const int t = tid_opaque(), lane = t & 63, wave = t >> 6; (void)t;
            float* outp = (l == DEPTH - 1) ? P.out : (float*)nullptr;
            for (int tok0 = (bid * 8 + wave) * 2; tok0 < T; tok0 += G * 8 * 2) {
                ln_tokens<2>([&](int q) { return (const u16*)h1b + (size_t)(tok0 + q) * 1024; },
                    [&](int q, int c) {
                        const unsigned char* srow = (const unsigned char*)slots + (size_t)(tok0 + q) * 9 * 1024;
                        f32x2 a0 = {0.f, 0.f}, a1 = a0, a2 = a0, a3 = a0;
#pragma unroll
                        for (int k = 0; k < 9; ++k) {
                            const u32x2 v = *(const u32x2*)(srow + k * 1024 + c);
                            a0 += __builtin_amdgcn_cvt_pk_f32_fp8((int)v[0], false); a1 += __builtin_amdgcn_cvt_pk_f32_fp8((int)v[0], true);
                            a2 += __builtin_amdgcn_cvt_pk_f32_fp8((int)v[1], false); a3 += __builtin_amdgcn_cvt_pk_f32_fp8((int)v[1], true);
                        }
                        a0 = a0 * 0.0625f; a1 = a1 * 0.0625f; a2 = a2 * 0.0625f; a3 = a3 * 0.0625f;
                        F8 s; s.lo = (f32x4){a0[0], a0[1], a1[0], a1[1]}; s.hi = (f32x4){a2[0], a2[1], a3[0], a3[1]};
                        return s;
                    },
                    P.ln2g + l * 1024, P.ln2b + l * 1024,
                    [&](int q, int c, const f32x4 y0, const f32x4 y1) {
                        if (outp) { *(f32x4*)(outp + (size_t)(tok0 + q) * 1024 + c) = y0; *(f32x4*)(outp + (size_t)(tok0 + q) * 1024 + c + 4) = y1; }
                        else { u32x4 p; p[0] = pack2(y0[0], y0[1]); p[1] = pack2(y0[2], y0[3]); p[2] = pack2(y1[0], y1[1]); p[3] = pack2(y1[2], y1[3]); *(u32x4*)(hb + (size_t)(tok0 + q) * 1024 + c) = p; }
                    }, lane);
            }
        }
        GRID_SYNC();
    };
    layer_body(0);
    layer_body(1);
}
#undef qkv
#undef obuf
#undef mix
#undef h1
#undef hcur
#undef logits
#undef gatebuf
#undef list
#undef hbuf
#undef slots
#undef hb
#undef h1b
#undef h1l
#undef hin
#undef count
}

extern "C" void kernel_launch(void* const* d_in, const int* in_sizes, int n_in, void* d_out, int out_size, void* d_ws, size_t ws_size, hipStream_t stream) {
    static int grid = 0;
    if (grid == 0) {
        if (n_in != 19 || ws_size < WS_END) { fprintf(stderr, "kernel_launch: unexpected n_in %d or ws_size %zu < %zu\n", n_in, ws_size, (size_t)WS_END); grid = -1; return; }
        int dev = 0, cus = 0, per_cu = 0;
        hipGetDevice(&dev);
        hipDeviceGetAttribute(&cus, hipDeviceAttributeMultiprocessorCount, dev);
        if (hipFuncSetAttribute((const void*)fwd_kernel, hipFuncAttributeMaxDynamicSharedMemorySize, LDS_BYTES) != hipSuccess) { fprintf(stderr, "hipFuncSetAttribute failed\n"); grid = -1; return; }
        hipOccupancyMaxActiveBlocksPerMultiprocessor(&per_cu, (const void*)fwd_kernel, NTHREADS, LDS_BYTES);
        if (per_cu < 1) { fprintf(stderr, "occupancy query says %d\n", per_cu); }
        grid = cus > 0 ? cus : 256;
    }
    if (grid < 0) return;
    hipMemsetAsync((char*)d_ws + WS_CTL, 0, CTL_BYTES, stream);
    Params p{};
    p.x = (const float*)d_in[0]; p.w_in = (const float*)d_in[1]; p.w_out = (const float*)d_in[2]; p.rel = (const float*)d_in[3]; p.lbl = (const float*)d_in[4];
    p.hg = (const float*)d_in[5]; p.sinks = (const float*)d_in[6]; p.ln1g = (const float*)d_in[7]; p.ln1b = (const float*)d_in[8]; p.rw = (const float*)d_in[9];
    p.rb = (const float*)d_in[10]; p.wg = (const float*)d_in[11]; p.wu = (const float*)d_in[12]; p.wd = (const float*)d_in[13]; p.sg = (const float*)d_in[14];
    p.su = (const float*)d_in[15]; p.sd = (const float*)d_in[16]; p.ln2g = (const float*)d_in[17]; p.ln2b = (const float*)d_in[18];
    p.out = (float*)d_out; p.ws = (char*)d_ws;
    hipLaunchKernelGGL(fwd_kernel, dim3(grid), dim3(NTHREADS), LDS_BYTES, stream, p);
}
```
